# Optimizing an MI355X kernel written in HIP

```python
import jax, jax.numpy as jnp
from jax import lax
import numpy as np

D_MODEL = 2048
BATCH = 4
SEQ = 2048
DEPTH = 1

CTX_LEN = 256
GRID_W = 64
MIX_W = D_MODEL
HEAD_SIZE = 128
ATTN_W = MIX_W // 2
N_HEADS = ATTN_W // HEAD_SIZE
QK_NOPE = 128
QK_ROPE = 64
V_DIM = HEAD_SIZE
Q_RANK = D_MODEL // 4
KV_RANK = D_MODEL // 8
CONV_W = MIX_W - ATTN_W
CONV_GROUPS = CONV_W // HEAD_SIZE
N_GROUPS = MIX_W // HEAD_SIZE
FFN_DIM = ((8 * D_MODEL // 3 + 127) // 128) * 128
IN_COLS = Q_RANK + KV_RANK + QK_ROPE + 3 * CONV_W
ROPE_BASE = 10000.0
Q_BLOCK = 128
EPS = 1e-6

kernel_name = "hybrid_mla_shortconv_dit_block"


def rms_norm(x, g):
    xf = x.astype(jnp.float32)
    y = xf * lax.rsqrt(jnp.mean(xf * xf, axis=-1, keepdims=True) + EPS)
    return (y * g.astype(jnp.float32)).astype(x.dtype)


def modulate(h, shift, scale):
    return h * (1 + scale) + shift


def axial_rope_tables(n_tok, dtype):
    rows = n_tok // GRID_W
    row = jnp.repeat(jnp.arange(rows), GRID_W).astype(jnp.float32)
    col = jnp.tile(jnp.arange(GRID_W), rows).astype(jnp.float32)
    axis_dim = QK_ROPE // 2
    inv = ROPE_BASE ** (-jnp.arange(0, axis_dim, 2, dtype=jnp.float32) / axis_dim)
    ang = jnp.concatenate([row[:, None] * inv, col[:, None] * inv], axis=-1)
    return jnp.cos(ang).astype(dtype), jnp.sin(ang).astype(dtype)


def apply_rope(x, cos, sin):
    xp = x.reshape(*x.shape[:-1], QK_ROPE // 2, 2)
    x1, x2 = xp[..., 0], xp[..., 1]
    return jnp.stack([x1 * cos - x2 * sin, x1 * sin + x2 * cos], axis=-1).reshape(x.shape)


def dwconv3(x, w, b):
    xp = jnp.pad(x, ((0, 0), (1, 1), (0, 0)))
    return xp[:, :-2] * w[0] + xp[:, 1:-1] * w[1] + xp[:, 2:] * w[2] + b


def split_projection(p):
    cuts = [Q_RANK, Q_RANK + KV_RANK, Q_RANK + KV_RANK + QK_ROPE,
            Q_RANK + KV_RANK + QK_ROPE + CONV_W, Q_RANK + KV_RANK + QK_ROPE + 2 * CONV_W]
    return jnp.split(p, cuts, axis=-1)


def mla_query(q_a, g_q_a, w_q_b, rope):
    b, l, _ = q_a.shape
    q = (rms_norm(q_a, g_q_a) @ w_q_b).reshape(b, l, N_HEADS, QK_NOPE + QK_ROPE).transpose(0, 2, 1, 3)
    q_nope, q_rope = q[..., :QK_NOPE], q[..., QK_NOPE:]
    if rope is not None:
        q_rope = apply_rope(q_rope, *rope)
    return jnp.concatenate([q_nope, q_rope], axis=-1)


def mla_key_value(kv_a, k_rope, g_kv_a, w_kv_b, rope):
    b, l, _ = kv_a.shape
    kv = (rms_norm(kv_a, g_kv_a) @ w_kv_b).reshape(b, l, N_HEADS, QK_NOPE + V_DIM).transpose(0, 2, 1, 3)
    k_nope, v = kv[..., :QK_NOPE], kv[..., QK_NOPE:]
    if rope is not None:
        k_rope = apply_rope(k_rope, *rope)
    k_rope = jnp.broadcast_to(k_rope[:, None], (b, N_HEADS, l, QK_ROPE))
    return jnp.concatenate([k_nope, k_rope], axis=-1), v


def block_attention(q, k, v):
    b, h, l, dqk = q.shape
    nb = l // Q_BLOCK
    scale = (QK_NOPE + QK_ROPE) ** -0.5
    qb = q.reshape(b, h, nb, Q_BLOCK, dqk).transpose(2, 0, 1, 3, 4)

    def one_block(qi):
        s = jnp.einsum("bhqd,bhkd->bhqk", qi, k).astype(jnp.float32) * scale
        p = jax.nn.softmax(s, axis=-1).astype(v.dtype)
        return jnp.einsum("bhqk,bhkd->bhqd", p, v)

    o = lax.map(one_block, qb)
    return o.transpose(1, 0, 3, 2, 4).reshape(b, l, h * V_DIM)


def short_conv(gate_b, gate_c, hc, w, bias):
    return gate_b * dwconv3(gate_c * hc, w, bias)


def merge_heads(att, conv, g_mix, w_out):
    b, l, _ = att.shape
    mix = jnp.concatenate([att, conv], axis=-1).reshape(b, l, N_GROUPS, HEAD_SIZE)
    mix = rms_norm(mix, g_mix.reshape(N_GROUPS, HEAD_SIZE)).reshape(b, l, MIX_W)
    return mix @ w_out


def conv_ffn(h, w_up, cw, cb, w_down):
    u = dwconv3(h @ w_up, cw, cb)
    a, g = jnp.split(u, 2, axis=-1)
    return (a * jax.nn.silu(g)) @ w_down


def setup_inputs(seed: int = 0) -> dict:
    key = jax.random.key(seed)
    ks = jax.random.split(key, 24)
    f32 = jnp.float32
    nrm = lambda k, shape, s: jax.random.normal(k, shape, f32) * s
    gain = lambda k, shape: 1.0 + 0.02 * jax.random.normal(k, shape, f32)
    return {
        "x": nrm(ks[0], (BATCH, SEQ, D_MODEL), 1.0),
        "c": nrm(ks[1], (BATCH, D_MODEL), 1.0),
        "ctx": nrm(ks[2], (BATCH, CTX_LEN, D_MODEL), 1.0),
        "c_ctx": nrm(ks[3], (D_MODEL,), 1.0),
        "w_ada": nrm(ks[4], (DEPTH, D_MODEL, 6 * D_MODEL), D_MODEL ** -0.5),
        "b_ada": nrm(ks[5], (DEPTH, 6 * D_MODEL), 0.01),
        "g_mix_norm": gain(ks[6], (DEPTH, D_MODEL)),
        "w_in": nrm(ks[7], (DEPTH, D_MODEL, IN_COLS), D_MODEL ** -0.5),
        "g_q_a": gain(ks[8], (DEPTH, Q_RANK)),
        "w_q_b": nrm(ks[9], (DEPTH, Q_RANK, N_HEADS * (QK_NOPE + QK_ROPE)), Q_RANK ** -0.5),
        "g_kv_a": gain(ks[10], (DEPTH, KV_RANK)),
        "w_kv_b": nrm(ks[11], (DEPTH, KV_RANK, N_HEADS * (QK_NOPE + V_DIM)), KV_RANK ** -0.5),
        "conv_w": nrm(ks[12], (DEPTH, 3, CONV_W), 3 ** -0.5),
        "conv_b": nrm(ks[13], (DEPTH, CONV_W), 0.01),
        "g_mix_out": gain(ks[14], (DEPTH, MIX_W)),
        "w_out": nrm(ks[15], (DEPTH, MIX_W, D_MODEL), MIX_W ** -0.5),
        "g_ffn_norm": gain(ks[16], (DEPTH, D_MODEL)),
        "w_up": nrm(ks[17], (DEPTH, D_MODEL, 2 * FFN_DIM), D_MODEL ** -0.5),
        "ffn_conv_w": nrm(ks[18], (DEPTH, 3, 2 * FFN_DIM), 3 ** -0.5),
        "ffn_conv_b": nrm(ks[19], (DEPTH, 2 * FFN_DIM), 0.01),
        "w_down": nrm(ks[20], (DEPTH, FFN_DIM, D_MODEL), FFN_DIM ** -0.5),
        "g_final": gain(ks[21], (D_MODEL,)),
    }


def reference(x, c, ctx, c_ctx, w_ada, b_ada, g_mix_norm, w_in, g_q_a, w_q_b, g_kv_a, w_kv_b,
              conv_w, conv_b, g_mix_out, w_out, g_ffn_norm, w_up, ffn_conv_w, ffn_conv_b,
              w_down, g_final):
    n_tok = x.shape[1]
    rope_lat = axial_rope_tables(n_tok, x.dtype)
    xc = ctx
    for l in range(DEPTH):
        last = l == DEPTH - 1
        mod_l = (jax.nn.silu(c) @ w_ada[l] + b_ada[l])[:, None, :]
        mod_c = (jax.nn.silu(c_ctx) @ w_ada[l] + b_ada[l])[None, None, :]
        sh_a, sc_a, gt_a, sh_f, sc_f, gt_f = jnp.split(mod_l, 6, axis=-1)
        csh_a, csc_a, cgt_a, csh_f, csc_f, cgt_f = jnp.split(mod_c, 6, axis=-1)

        h_l = modulate(rms_norm(x, g_mix_norm[l]), sh_a, sc_a)
        h_c = modulate(rms_norm(xc, g_mix_norm[l]), csh_a, csc_a)
        qa_l, kva_l, kr_l, cb_l, cc_l, ch_l = split_projection(h_l @ w_in[l])
        qa_c, kva_c, kr_c, cb_c, cc_c, ch_c = split_projection(h_c @ w_in[l])

        k_l, v_l = mla_key_value(kva_l, kr_l, g_kv_a[l], w_kv_b[l], rope_lat)
        k_c, v_c = mla_key_value(kva_c, kr_c, g_kv_a[l], w_kv_b[l], None)
        q_l = mla_query(qa_l, g_q_a[l], w_q_b[l], rope_lat)
        att_l = block_attention(q_l, jnp.concatenate([k_l, k_c], axis=2),
                                jnp.concatenate([v_l, v_c], axis=2))
        conv_l = short_conv(cb_l, cc_l, ch_l, conv_w[l], conv_b[l])
        x = x + gt_a * merge_heads(att_l, conv_l, g_mix_out[l], w_out[l])

        if not last:
            q_c = mla_query(qa_c, g_q_a[l], w_q_b[l], None)
            att_c = block_attention(q_c, k_c, v_c)
            conv_c = short_conv(cb_c, cc_c, ch_c, conv_w[l], conv_b[l])
            xc = xc + cgt_a * merge_heads(att_c, conv_c, g_mix_out[l], w_out[l])
            hf_c = modulate(rms_norm(xc, g_ffn_norm[l]), csh_f, csc_f)
            xc = xc + cgt_f * conv_ffn(hf_c, w_up[l], ffn_conv_w[l], ffn_conv_b[l], w_down[l])

        hf_l = modulate(rms_norm(x, g_ffn_norm[l]), sh_f, sc_f)
        x = x + gt_f * conv_ffn(hf_l, w_up[l], ffn_conv_w[l], ffn_conv_b[l], w_down[l])
    return rms_norm(x, g_final)
```

```cpp
#include <hip/hip_runtime.h>
#include <hip/hip_cooperative_groups.h>
#include <cstdio>
#include <cstdint>
namespace cg = cooperative_groups;

#define LAS __attribute__((address_space(3)))
typedef unsigned short bf16_t;
typedef short bf16x8 __attribute__((ext_vector_type(8)));
typedef short s16x4 __attribute__((ext_vector_type(4)));
typedef float f32x2 __attribute__((ext_vector_type(2)));
typedef float f32x4 __attribute__((ext_vector_type(4)));
typedef float f32x16 __attribute__((ext_vector_type(16)));
typedef unsigned u32x2 __attribute__((ext_vector_type(2)));
typedef unsigned u32x4 __attribute__((ext_vector_type(4)));

constexpr int DM = 2048, NB = 4, SEQ = 2048, CTXL = 256;
constexpr int ML = NB * SEQ;
constexpr int MC = NB * CTXL;
constexpr int MT = ML + MC;
constexpr int QRANK = 512, KVRANK = 256, ROPE = 64, CONVW = 1024, NH = 8, DQK = 192, DV = 128;
constexpr int INC = 3904, INP = 4096;
constexpr int FFN = 5504, FFN2 = 11008;
constexpr int QW = NH * DQK;
constexpr int KVW = NH * 256;
constexpr int C_QA = 0, C_KVA = 512, C_KR = 768, C_CB = 832, C_CC = 1856, C_CH = 2880;
constexpr float EPS = 1e-6f;
constexpr int NWAVES = 8, NTHR = 512;
constexpr int LDS_BYTES = 163840;

constexpr size_t MiB = 1u << 20;
constexpr size_t WS_MOD = 0;
constexpr size_t MOD_BYTES = 5 * 12288 * 4;
constexpr size_t WS_BAR = 256 * 1024;
constexpr size_t WS_CNT = 320 * 1024;
constexpr size_t WS_MODCNT = 344 * 1024;
constexpr size_t WS_ZERO_BYTES = 512 * 1024;
constexpr size_t WS_ROPE = 512 * 1024;
constexpr size_t WS_WDOWN = 1 * MiB + 0;
constexpr size_t WS_WIN = 23 * MiB;
constexpr size_t WS_WQB = 39 * MiB;
constexpr size_t WS_WKVB = 41 * MiB;
constexpr size_t WS_WOUT = 42 * MiB;
constexpr size_t WS_WUP = 50 * MiB;
constexpr size_t WS_H = 93 * MiB;
constexpr size_t WS_RAW = 129 * MiB;
constexpr size_t WS_ACT = 141 * MiB;
constexpr size_t WS_P = 129 * MiB;
constexpr size_t WS_QN = 201 * MiB;
constexpr size_t WS_KVN = 209 * MiB;
constexpr size_t WS_KR = 214 * MiB;
constexpr size_t WS_Q = 216 * MiB;
constexpr size_t WS_KV = 240 * MiB;
constexpr size_t WS_MIXN = 276 * MiB;
constexpr size_t WS_U = 129 * MiB;
constexpr size_t WS_SLAB = 308 * MiB;
constexpr size_t WS_XBUF = 324 * MiB;
constexpr size_t WS_END = 325 * MiB;

__device__ __forceinline__ int otid() { int t = threadIdx.x; asm volatile("" : "+v"(t)); return t; }
__device__ __forceinline__ unsigned cvt_pk_bf16(float lo, float hi) { unsigned r; asm volatile("v_cvt_pk_bf16_f32 %0, %1, %2" : "=v"(r) : "v"(lo), "v"(hi)); return r; }
__device__ __forceinline__ float bf_lo(unsigned w) { return __uint_as_float(w << 16); }
__device__ __forceinline__ float bf_hi(unsigned w) { return __uint_as_float(w & 0xffff0000u); }
__device__ __forceinline__ void unpack8(const u32x4 w, float* f) { f[0] = bf_lo(w.x); f[1] = bf_hi(w.x); f[2] = bf_lo(w.y); f[3] = bf_hi(w.y); f[4] = bf_lo(w.z); f[5] = bf_hi(w.z); f[6] = bf_lo(w.w); f[7] = bf_hi(w.w); }
__device__ __forceinline__ u32x4 pack8(const float* f) { u32x4 w; w.x = cvt_pk_bf16(f[0], f[1]); w.y = cvt_pk_bf16(f[2], f[3]); w.z = cvt_pk_bf16(f[4], f[5]); w.w = cvt_pk_bf16(f[6], f[7]); return w; }
__device__ __forceinline__ float wave_sum(float v) {
#pragma unroll
    for (int o = 1; o < 64; o <<= 1) v += __shfl_xor(v, o);
    return v;
}
__device__ __forceinline__ void st16_wt(void* p, u32x4 v) { asm volatile("global_store_dwordx4 %0, %1, off sc1\n\ts_nop 1" :: "v"(p), "v"(v) : "memory"); }
__device__ __forceinline__ float silu_f(float x) { return x * __builtin_amdgcn_rcpf(1.0f + __builtin_amdgcn_exp2f(-1.4426950408889634f * x)); }

namespace pg8 {
constexpr int BM = 256, BK = 64, HALF = 128, HTB = HALF * BK * 2, STAGE_BYTES = 8 * HTB, NXCD = 8, WGM = 4;
__host__ __device__ __forceinline__ int lds_byte(int r, int c) { const int st = (r >> 4) * 2 + (c >> 5), rr = r & 15, cc = c & 31, ob = rr * 64 + cc * 2; return st * 1024 + (ob ^ (((ob >> 9) & 1) << 5)); }
__host__ __device__ __forceinline__ void stage_rc(int b, int& R, int& C) { const int st = b / 1024, sb = b % 1024, swz = sb ^ (((sb >> 9) & 1) << 5); R = (st >> 1) * 16 + swz / 64; C = (st & 1) * 32 + (swz % 64) / 2; }
__host__ __device__ __forceinline__ int perm32(int rho) { const int n = rho >> 4, i = rho & 15; return 8 * (i >> 2) + 4 * n + (i & 3); }
struct Unit { int pm, pn, ko; };
struct Gemm { const bf16_t* A; const bf16_t* Bt; int M, N, K, lda, ldb; };
struct StaticOrder {
    int nM, nN, nwg, G, c;
    __device__ void init(int M, int N, int G_, int c_) { nM = M / BM; nN = N / BM; nwg = nM * nN; G = G_; c = c_; }
    __device__ bool next(int i, Unit& u) const {
        const long L = (long)i * G + c; if (L >= nwg) return false;
        int wgid = (int)L; { const int q = nwg / NXCD, r = nwg % NXCD, xcd = wgid % NXCD, off = wgid / NXCD; wgid = (xcd < r ? xcd * (q + 1) : r * (q + 1) + (xcd - r) * q) + off; }
        const int nig = WGM * nN, gid = wgid / nig, fm = gid * WGM, gsz = (nM - fm) < WGM ? (nM - fm) : WGM;
        u.pm = fm + ((wgid % nig) % gsz); u.pn = (wgid % nig) / gsz; u.ko = 0; return true;
    }
};
struct EpiBf16 {
    static constexpr bool PERM = true, AFTER_DRAIN = false;
    bf16_t* O; int ldc;
    __device__ __forceinline__ void operator()(const f32x4 (&acc)[2][2][4][2], const Unit& u, int wr, int wc, int fr, int fq) const {
        const int row0 = u.pm * BM + wr * 64 + fr, col0 = u.pn * BM + wc * 32 + 8 * fq;
#pragma unroll
        for (int ai = 0; ai < 2; ++ai)
#pragma unroll
            for (int m = 0; m < 4; ++m) { bf16_t* rowp = O + (size_t)(row0 + ai * HALF + m * 16) * ldc + col0;
#pragma unroll
                for (int bj = 0; bj < 2; ++bj) { const f32x4 v0 = acc[ai][bj][m][0], v1 = acc[ai][bj][m][1];
                    u32x4 w; w.x = cvt_pk_bf16(v0[0], v0[1]); w.y = cvt_pk_bf16(v0[2], v0[3]); w.z = cvt_pk_bf16(v1[0], v1[1]); w.w = cvt_pk_bf16(v1[2], v1[3]);
                    st16_wt(rowp + bj * HALF, w); } }
    }
};
struct EpiRopeQ {
    static constexpr bool PERM = true, AFTER_DRAIN = false;
    bf16_t* O; const f32x2* tab;
    __device__ __forceinline__ void operator()(const f32x4 (&acc)[2][2][4][2], const Unit& u, int wr, int wc, int fr, int fq) const {
        const int row0 = u.pm * BM + wr * 64 + fr, col0 = u.pn * BM + wc * 32 + 8 * fq;
#pragma unroll
        for (int bj = 0; bj < 2; ++bj) {
            const int col = col0 + bj * HALF; const int d = col % DQK; const bool rot = d >= 128; const int i0 = (d - 128) >> 1;
#pragma unroll
            for (int ai = 0; ai < 2; ++ai)
#pragma unroll
                for (int m = 0; m < 4; ++m) { const int row = row0 + ai * HALF + m * 16;
                    f32x4 v0 = acc[ai][bj][m][0], v1 = acc[ai][bj][m][1];
                    if (rot) { const f32x4* tp = (const f32x4*)(tab + (size_t)(row & (SEQ - 1)) * 32 + i0); const f32x4 c0 = tp[0], c1 = tp[1];
                        const f32x4 a = v0, b = v1;
                        v0[0] = a[0] * c0[0] - a[1] * c0[1]; v0[1] = a[0] * c0[1] + a[1] * c0[0]; v0[2] = a[2] * c0[2] - a[3] * c0[3]; v0[3] = a[2] * c0[3] + a[3] * c0[2];
                        v1[0] = b[0] * c1[0] - b[1] * c1[1]; v1[1] = b[0] * c1[1] + b[1] * c1[0]; v1[2] = b[2] * c1[2] - b[3] * c1[3]; v1[3] = b[2] * c1[3] + b[3] * c1[2]; }
                    u32x4 w; w.x = cvt_pk_bf16(v0[0], v0[1]); w.y = cvt_pk_bf16(v0[2], v0[3]); w.z = cvt_pk_bf16(v1[0], v1[1]); w.w = cvt_pk_bf16(v1[2], v1[3]);
                    st16_wt(O + (size_t)row * QW + col, w); }
        }
    }
};
struct CtxSplitOrder {
    int c;
    __device__ bool next(int i, Unit& u) const { if (i != 0 || c >= 64) return false; u.pm = 32 + (c >> 4); u.pn = 2 + ((c >> 3) & 1); u.ko = (c & 7) * 256; return true; }
};
struct EpiSlab {
    static constexpr bool PERM = false, AFTER_DRAIN = false;
    float* S;
    __device__ __forceinline__ void operator()(const f32x4 (&acc)[2][2][4][2], const Unit& u, int wr, int wc, int fr, int fq) const {
        float* sp = S + (size_t)(u.ko >> 8) * (1024 * 512) + (size_t)((u.pm - 32) * BM + wr * 64 + fr) * 512 + (u.pn - 2) * BM + wc * 32 + 4 * fq;
#pragma unroll
        for (int ai = 0; ai < 2; ++ai)
#pragma unroll
            for (int m = 0; m < 4; ++m)
#pragma unroll
                for (int bj = 0; bj < 2; ++bj)
#pragma unroll
                    for (int n = 0; n < 2; ++n) *(f32x4*)(sp + (size_t)(ai * HALF + m * 16) * 512 + bj * HALF + n * 16) = acc[ai][bj][m][n];
    }
};
struct EpiResGate {
    static constexpr bool PERM = false, AFTER_DRAIN = false;
    const float* base; float* out; const float* gate;
    __device__ __forceinline__ void operator()(const f32x4 (&acc)[2][2][4][2], const Unit& u, int wr, int wc, int fr, int fq) const {
        const int col0 = u.pn * BM + wc * 32 + 4 * fq; const float* gp = gate + (size_t)(u.pm >> 3) * 12288 + col0;
        f32x4 gv[2][2];
#pragma unroll
        for (int bj = 0; bj < 2; ++bj)
#pragma unroll
            for (int n = 0; n < 2; ++n) gv[bj][n] = *(const f32x4*)(gp + bj * HALF + n * 16);
#pragma unroll
        for (int ai = 0; ai < 2; ++ai)
#pragma unroll
            for (int m = 0; m < 4; ++m) { const size_t off = (size_t)(u.pm * BM + ai * HALF + wr * 64 + m * 16 + fr) * DM + col0;
#pragma unroll
                for (int bj = 0; bj < 2; ++bj)
#pragma unroll
                    for (int n = 0; n < 2; ++n) { const f32x4 bs = *(const f32x4*)(base + off + bj * HALF + n * 16);
                        *(f32x4*)(out + off + bj * HALF + n * 16) = bs + gv[bj][n] * acc[ai][bj][m][n]; }
                if (m & 1) asm volatile("" ::: "memory"); }
    }
};

template <int SEL> __device__ __forceinline__ void fmac_dpp(float& d, float x, float w) {
    if (SEL == 0)      asm("v_fmac_f32_dpp %0, %1, %2 row_shr:1 row_mask:0xf bank_mask:0xf bound_ctrl:1" : "+v"(d) : "v"(x), "v"(w));
    else if (SEL == 1) asm("v_fmac_f32_dpp %0, %1, %2 row_shl:1 row_mask:0xf bank_mask:0xf bound_ctrl:1" : "+v"(d) : "v"(x), "v"(w));
    else if (SEL == 2) asm("v_fmac_f32_dpp %0, %1, %2 row_ror:1 row_mask:0xf bank_mask:0xf" : "+v"(d) : "v"(x), "v"(w));
    else               asm("v_fmac_f32_dpp %0, %1, %2 row_ror:15 row_mask:0xf bank_mask:0xf" : "+v"(d) : "v"(x), "v"(w));
}
struct EpiAct {
    static constexpr bool PERM = true, AFTER_DRAIN = false;
    bf16_t* ACT; bf16_t* RAW; const float* cw; const float* cb;
    __device__ __forceinline__ void operator()(const f32x4 (&acc)[2][2][4][2], const Unit& u, int wr, int wc, int fr, int fq) const {
        const int jc = u.pn * 128 + wc * 32 + 8 * fq;
        const int tc = u.pn * BM + wc * 32 + 8 * fq;
        const float m0 = (fr == 0) ? 1.f : 0.f, m15 = (fr == 15) ? 1.f : 0.f;
        u32x2 stash[2][4];
#pragma unroll
        for (int n = 0; n < 2; ++n) {
            const int j = jc + 4 * n;
            const f32x4 a0 = *(const f32x4*)(cw + j), a1 = *(const f32x4*)(cw + FFN2 + j), a2 = *(const f32x4*)(cw + 2 * FFN2 + j), ab = *(const f32x4*)(cb + j);
            const f32x4 g0 = *(const f32x4*)(cw + FFN + j), g1 = *(const f32x4*)(cw + FFN2 + FFN + j), g2 = *(const f32x4*)(cw + 2 * FFN2 + FFN + j), gb = *(const f32x4*)(cb + FFN + j);
            const f32x4 a0z = a0 * m0, a2z = a2 * m15, g0z = g0 * m0, g2z = g2 * m15;
#pragma unroll
            for (int ai = 0; ai < 2; ++ai) {
                const int rowb = u.pm * BM + ai * HALF + wr * 64;
#pragma unroll
                for (int m = 0; m < 4; ++m) {
                    f32x4 ya, yg;
#pragma unroll
                    for (int e = 0; e < 4; ++e) {
                        const float xa = acc[ai][0][m][n][e], xg = acc[ai][1][m][n][e];
                        float ca = ab[e] + a1[e] * xa, cg = gb[e] + g1[e] * xg;
                        fmac_dpp<0>(ca, xa, a0[e]); fmac_dpp<0>(cg, xg, g0[e]);
                        fmac_dpp<1>(ca, xa, a2[e]); fmac_dpp<1>(cg, xg, g2[e]);
                        if (m > 0) { fmac_dpp<2>(ca, acc[ai][0][m - 1][n][e], a0z[e]); fmac_dpp<2>(cg, acc[ai][1][m - 1][n][e], g0z[e]); }
                        if (m < 3) { fmac_dpp<3>(ca, acc[ai][0][m + 1][n][e], a2z[e]); fmac_dpp<3>(cg, acc[ai][1][m + 1][n][e], g2z[e]); }
                        ya[e] = ca; yg[e] = cg;
                    }
                    u32x2 w;
                    w.x = cvt_pk_bf16(ya[0] * silu_f(yg[0]), ya[1] * silu_f(yg[1])); w.y = cvt_pk_bf16(ya[2] * silu_f(yg[2]), ya[3] * silu_f(yg[3]));
                    if (n == 0) stash[ai][m] = w;
                    else { u32x4 w4; w4.x = stash[ai][m].x; w4.y = stash[ai][m].y; w4.z = w.x; w4.w = w.y; st16_wt(ACT + (size_t)(rowb + m * 16 + fr) * FFN + jc, w4); }
                    if ((m == 0 && fr < 2) || (m == 3 && fr >= 14)) {
                        const int idx = (m == 0) ? fr : fr - 12;
                        bf16_t* rp = RAW + (size_t)((rowb >> 6) * 4 + idx) * FFN2 + tc + 4 * n;
                        const f32x4 ra = acc[ai][0][m][n], rg = acc[ai][1][m][n];
                        u32x2 wa, wg; wa.x = cvt_pk_bf16(ra[0], ra[1]); wa.y = cvt_pk_bf16(ra[2], ra[3]); wg.x = cvt_pk_bf16(rg[0], rg[1]); wg.y = cvt_pk_bf16(rg[2], rg[3]);
                        *(u32x2*)rp = wa; *(u32x2*)(rp + HALF) = wg; }
                }
            }
        }
    }
};

struct RowStats {
    float* xbuf;
    unsigned* cnt;
    __device__ __forceinline__ void run(const f32x4 (&v)[2][2][4][2], const Unit& u, int wr, int wc, int fr, int fq, LAS unsigned char* lds, int wid, int lane) const {
        LAS float* P = (LAS float*)lds;
        LAS float* S = (LAS float*)(lds + 8192);
#pragma unroll
        for (int ai = 0; ai < 2; ++ai)
#pragma unroll
            for (int m = 0; m < 4; ++m) { float q = 0.f;
#pragma unroll
                for (int bj = 0; bj < 2; ++bj)
#pragma unroll
                    for (int n = 0; n < 2; ++n) { const f32x4 x = v[ai][bj][m][n]; q += (x[0] * x[0] + x[1] * x[1]) + (x[2] * x[2] + x[3] * x[3]); }
                q += __shfl_xor(q, 16); q += __shfl_xor(q, 32);
                if (fq == 0) P[(ai * HALF + wr * 64 + m * 16 + fr) * 4 + wc] = q; }
        asm volatile("s_waitcnt lgkmcnt(0)" ::: "memory"); __builtin_amdgcn_s_barrier(); asm volatile("" ::: "memory");
        const int row = wid * 32 + (lane & 31);
        if (lane < 32) { const float t = (P[row * 4 + 0] + P[row * 4 + 1]) + (P[row * 4 + 2] + P[row * 4 + 3]);
            __hip_atomic_store(xbuf + ((size_t)(u.pm * BM + row) * 8 + u.pn), t, __ATOMIC_RELAXED, __HIP_MEMORY_SCOPE_AGENT); }
        asm volatile("s_waitcnt vmcnt(0)" ::: "memory");
        if (lane == 0) __hip_atomic_fetch_add(cnt + 64 * u.pm, 1u, __ATOMIC_RELAXED, __HIP_MEMORY_SCOPE_AGENT);
        if (wid == 0) { unsigned sp = 0;
            while ((unsigned)__builtin_amdgcn_readfirstlane(__hip_atomic_load(cnt + 64 * u.pm, __ATOMIC_RELAXED, __HIP_MEMORY_SCOPE_AGENT)) < 64u) { __builtin_amdgcn_s_sleep(2); if (++sp > (1u << 20)) break; }
            __builtin_amdgcn_fence(__ATOMIC_ACQUIRE, "agent"); }
        asm volatile("s_waitcnt vmcnt(0) lgkmcnt(0)" ::: "memory"); __builtin_amdgcn_s_barrier(); asm volatile("" ::: "memory");
        if (lane < 32) { const float* slot = xbuf + (size_t)(u.pm * BM + row) * 8; float t = 0.f;
#pragma unroll
            for (int k = 0; k < 8; ++k) t += __hip_atomic_load(slot + k, __ATOMIC_RELAXED, __HIP_MEMORY_SCOPE_AGENT);
            S[row] = rsqrtf(t * (1.0f / DM) + EPS); }
        asm volatile("s_waitcnt lgkmcnt(0)" ::: "memory"); __builtin_amdgcn_s_barrier(); asm volatile("" ::: "memory");
    }
};
struct EpiResGateNormMod {
    static constexpr bool PERM = false, AFTER_DRAIN = true;
    const float* base; float* out; const float* gate; const float* g; const float* sh; const float* sc; bf16_t* HF; RowStats st;
    __device__ __forceinline__ void fused(f32x4 (&acc)[2][2][4][2], const Unit& u, int wr, int wc, int fr, int fq, LAS unsigned char* lds, int wid, int lane) const {
        const LAS float* S = (const LAS float*)(lds + 8192);
        const int col0 = u.pn * BM + wc * 32 + 4 * fq; const size_t mo = (size_t)(u.pm >> 3) * 12288 + col0;
        { f32x4 gv[2][2];
#pragma unroll
          for (int bj = 0; bj < 2; ++bj)
#pragma unroll
            for (int n = 0; n < 2; ++n) gv[bj][n] = *(const f32x4*)(gate + mo + bj * HALF + n * 16);
#pragma unroll
          for (int ai = 0; ai < 2; ++ai)
#pragma unroll
            for (int m = 0; m < 4; ++m) { const size_t off = (size_t)(u.pm * BM + ai * HALF + wr * 64 + m * 16 + fr) * DM + col0;
#pragma unroll
                for (int bj = 0; bj < 2; ++bj)
#pragma unroll
                    for (int n = 0; n < 2; ++n) { const f32x4 bs = __builtin_nontemporal_load((const f32x4*)(base + off + bj * HALF + n * 16)); acc[ai][bj][m][n] = bs + gv[bj][n] * acc[ai][bj][m][n]; }
                asm volatile("" : "+v"(acc[ai][0][m][0]), "+v"(acc[ai][0][m][1]), "+v"(acc[ai][1][m][0]), "+v"(acc[ai][1][m][1]));
                if (m == 3) asm volatile("" ::: "memory"); } }
        st.run(acc, u, wr, wc, fr, fq, lds, wid, lane);
        f32x4 A[2][2], Bv[2][2];
#pragma unroll
        for (int bj = 0; bj < 2; ++bj)
#pragma unroll
            for (int n = 0; n < 2; ++n) { const f32x4 gg = *(const f32x4*)(g + col0 + bj * HALF + n * 16), s4 = *(const f32x4*)(sc + mo + bj * HALF + n * 16);
                A[bj][n] = gg * (s4 + 1.0f); Bv[bj][n] = *(const f32x4*)(sh + mo + bj * HALF + n * 16); }
#pragma unroll
        for (int ai = 0; ai < 2; ++ai)
#pragma unroll
            for (int m = 0; m < 4; ++m) { const int r = ai * HALF + wr * 64 + m * 16 + fr; const float rs = S[r]; const size_t off = (size_t)(u.pm * BM + r) * DM + col0;
#pragma unroll
                for (int bj = 0; bj < 2; ++bj)
#pragma unroll
                    for (int n = 0; n < 2; ++n) { const f32x4 x1 = acc[ai][bj][m][n]; __builtin_nontemporal_store(x1, (f32x4*)(out + off + bj * HALF + n * 16));
                        const f32x4 y = x1 * rs * A[bj][n] + Bv[bj][n]; u32x2 w; w.x = cvt_pk_bf16(y[0], y[1]); w.y = cvt_pk_bf16(y[2], y[3]);
                        *(u32x2*)(HF + off + bj * HALF + n * 16) = w; }
                asm volatile("" ::: "memory"); }
    }
};
struct EpiResGateNormFinal {
    static constexpr bool PERM = false, AFTER_DRAIN = true;
    const float* base; float* out; const float* gate; const float* g; RowStats st;
    __device__ __forceinline__ void fused(f32x4 (&acc)[2][2][4][2], const Unit& u, int wr, int wc, int fr, int fq, LAS unsigned char* lds, int wid, int lane) const {
        const LAS float* S = (const LAS float*)(lds + 8192);
        const int col0 = u.pn * BM + wc * 32 + 4 * fq; const size_t mo = (size_t)(u.pm >> 3) * 12288 + col0;
        { f32x4 gv[2][2];
#pragma unroll
          for (int bj = 0; bj < 2; ++bj)
#pragma unroll
            for (int n = 0; n < 2; ++n) gv[bj][n] = *(const f32x4*)(gate + mo + bj * HALF + n * 16);
#pragma unroll
          for (int ai = 0; ai < 2; ++ai)
#pragma unroll
            for (int m = 0; m < 4; ++m) { const size_t off = (size_t)(u.pm * BM + ai * HALF + wr * 64 + m * 16 + fr) * DM + col0;
#pragma unroll
                for (int bj = 0; bj < 2; ++bj)
#pragma unroll
                    for (int n = 0; n < 2; ++n) { const f32x4 bs = __builtin_nontemporal_load((const f32x4*)(base + off + bj * HALF + n * 16)); acc[ai][bj][m][n] = bs + gv[bj][n] * acc[ai][bj][m][n]; }
                asm volatile("" : "+v"(acc[ai][0][m][0]), "+v"(acc[ai][0][m][1]), "+v"(acc[ai][1][m][0]), "+v"(acc[ai][1][m][1]));
                if (m == 3) asm volatile("" ::: "memory"); } }
        st.run(acc, u, wr, wc, fr, fq, lds, wid, lane);
        f32x4 A[2][2];
#pragma unroll
        for (int bj = 0; bj < 2; ++bj)
#pragma unroll
            for (int n = 0; n < 2; ++n) A[bj][n] = *(const f32x4*)(g + col0 + bj * HALF + n * 16);
#pragma unroll
        for (int ai = 0; ai < 2; ++ai)
#pragma unroll
            for (int m = 0; m < 4; ++m) { const int r = ai * HALF + wr * 64 + m * 16 + fr; const float rs = S[r]; const size_t off = (size_t)(u.pm * BM + r) * DM + col0;
#pragma unroll
                for (int bj = 0; bj < 2; ++bj)
#pragma unroll
                    for (int n = 0; n < 2; ++n) __builtin_nontemporal_store(acc[ai][bj][m][n] * rs * A[bj][n], (f32x4*)(out + off + bj * HALF + n * 16));
                asm volatile("" ::: "memory"); }
    }
};

template <class Epi, class Sched, bool ALIGN_EPI>
__device__ __forceinline__ void gemm_phase(LAS unsigned char* lds, const Gemm g, const Sched& S, const Epi& E) {
    const int tid = otid(), wid = __builtin_amdgcn_readfirstlane(tid >> 6), lane = tid & 63, wr = wid >> 2, wc = wid & 3, fr = lane & 15, fq = lane >> 4;
    const int K = g.K, nt = K / BK;
    unsigned voffA[2], voffB[2];
#pragma unroll
    for (int i = 0; i < 2; ++i) { int R, C; stage_rc(tid * 16 + i * 8192, R, C); const int Rb = Epi::PERM ? ((R & ~31) + perm32(R & 31)) : R;
        voffA[i] = (unsigned)(R * g.lda + C) * 2u; voffB[i] = (unsigned)(Rb * g.ldb + C) * 2u; }
    const size_t kstep = (size_t)(BK * 2);
    const size_t hstepA = (size_t)HALF * g.lda * 2, hstepB = (size_t)HALF * g.ldb * 2;
    const size_t tstepA = 2 * hstepA, tstepB = 2 * hstepB;
    const unsigned ldsw = (unsigned)wid * 1024u;
    const int aoff = lds_byte(wr * 64 + fr, fq * 8), boff = lds_byte(wc * 32 + fr, fq * 8);
#define PG8_SA(b, h) (((b) * 2 + (h)) * HTB)
#define PG8_SB(b, h) ((4 + (b) * 2 + (h)) * HTB)
#define PG8_STAGE(bufoff, gbase, voff) do { _Pragma("unroll") for (int _i = 0; _i < 2; ++_i) \
        __builtin_amdgcn_global_load_lds((const unsigned*)((const char*)(gbase) + (voff)[_i]), (LAS unsigned*)(lds + (bufoff) + ldsw + _i * 8192), 16, 0, 0); } while (0)
#define PG8_LDA(dst, b, h) do { _Pragma("unroll") for (int m = 0; m < 4; ++m) _Pragma("unroll") for (int k = 0; k < 2; ++k) dst[m][k] = *(const LAS bf16x8*)(lds + PG8_SA(b, h) + aoff + m * 2048 + k * 1024); } while (0)
#define PG8_LDB(dst, b, h) do { _Pragma("unroll") for (int n = 0; n < 2; ++n) _Pragma("unroll") for (int k = 0; k < 2; ++k) dst[n][k] = *(const LAS bf16x8*)(lds + PG8_SB(b, h) + boff + n * 2048 + k * 1024); } while (0)
#define PG8_MMA(ai, bj, At, Bt) do { __builtin_amdgcn_s_setprio(1); _Pragma("unroll") for (int m = 0; m < 4; ++m) _Pragma("unroll") for (int n = 0; n < 2; ++n) _Pragma("unroll") for (int k = 0; k < 2; ++k) \
        acc[ai][bj][m][n] = __builtin_amdgcn_mfma_f32_16x16x32_bf16(Bt[n][k], At[m][k], acc[ai][bj][m][n], 0, 0, 0); __builtin_amdgcn_s_setprio(0); } while (0)
#define PG8_WAIT_V(n) asm volatile("s_waitcnt vmcnt(" #n ")" ::: "memory")
#define PG8_WAIT_L(n) asm volatile("s_waitcnt lgkmcnt(" #n ")" ::: "memory")
#define PG8_BAR __builtin_amdgcn_s_barrier()
#define PG8_SCHED __builtin_amdgcn_sched_barrier(0)
    Unit cur, nxt; int ui = 0;
    if (!S.next(0, cur)) return;
    f32x4 acc[2][2][4][2];
#pragma unroll
    for (int a = 0; a < 2; ++a)
#pragma unroll
        for (int b = 0; b < 2; ++b)
#pragma unroll
            for (int m = 0; m < 4; ++m)
#pragma unroll
                for (int n = 0; n < 2; ++n) acc[a][b][m][n] = (f32x4){0.f, 0.f, 0.f, 0.f};
    bf16x8 At[4][2], B0[2][2], B1[2][2];
    const char* cA = (const char*)g.A + (size_t)cur.pm * tstepA + (size_t)cur.ko * 2; const char* cB = (const char*)g.Bt + (size_t)cur.pn * tstepB + (size_t)cur.ko * 2;
    PG8_STAGE(PG8_SB(0, 0), cB, voffB); PG8_STAGE(PG8_SB(0, 1), cB + hstepB, voffB); PG8_STAGE(PG8_SA(0, 0), cA, voffA); PG8_STAGE(PG8_SA(0, 1), cA + hstepA, voffA);
    if (wr == 1) PG8_BAR;
    PG8_WAIT_V(2); PG8_BAR;
    PG8_STAGE(PG8_SB(1, 0), cB + kstep, voffB); PG8_STAGE(PG8_SA(1, 0), cA + kstep, voffA); PG8_STAGE(PG8_SB(1, 1), cB + hstepB + kstep, voffB);
    PG8_WAIT_V(6); PG8_BAR;
    for (;;) {
        const bool has_next = S.next(ui + 1, nxt);
        const char* nA = has_next ? (const char*)g.A + (size_t)nxt.pm * tstepA + (size_t)nxt.ko * 2 : cA; const char* nB = has_next ? (const char*)g.Bt + (size_t)nxt.pn * tstepB + (size_t)nxt.ko * 2 : cB;
        for (int t = 0; t < nt; t += 2) {
            const bool last = (t == nt - 2);
            const char* a1 = cA + (size_t)(t + 1) * kstep;
            const char* a2 = last ? nA : cA + (size_t)(t + 2) * kstep; const char* b2 = last ? nB : cB + (size_t)(t + 2) * kstep;
            const char* a3 = a2 + kstep; const char* b3 = b2 + kstep;
            PG8_LDB(B0, 0, 0); PG8_LDB(B1, 0, 1); PG8_SCHED; PG8_LDA(At, 0, 0); PG8_STAGE(PG8_SA(1, 1), a1 + hstepA, voffA);
            PG8_WAIT_V(8); PG8_WAIT_L(0); PG8_BAR; PG8_MMA(0, 0, At, B0); PG8_MMA(0, 1, At, B1); PG8_BAR; PG8_SCHED;
            PG8_LDA(At, 0, 1); PG8_STAGE(PG8_SB(0, 0), b2, voffB); PG8_STAGE(PG8_SB(0, 1), b2 + hstepB, voffB); PG8_STAGE(PG8_SA(0, 0), a2, voffA);
            PG8_WAIT_V(8); PG8_WAIT_L(0); PG8_BAR; PG8_MMA(1, 0, At, B0); PG8_MMA(1, 1, At, B1); PG8_BAR; PG8_SCHED;
            PG8_LDB(B0, 1, 0); PG8_LDB(B1, 1, 1); PG8_SCHED; PG8_LDA(At, 1, 0); PG8_STAGE(PG8_SA(0, 1), a2 + hstepA, voffA);
            PG8_WAIT_V(8); PG8_WAIT_L(0); PG8_BAR; PG8_MMA(0, 0, At, B0); PG8_MMA(0, 1, At, B1); PG8_BAR; PG8_SCHED;
            PG8_LDA(At, 1, 1); PG8_STAGE(PG8_SB(1, 0), b3, voffB); PG8_STAGE(PG8_SB(1, 1), b3 + hstepB, voffB); PG8_STAGE(PG8_SA(1, 0), a3, voffA);
            PG8_WAIT_V(8); PG8_WAIT_L(0); PG8_BAR; PG8_MMA(1, 0, At, B0); PG8_MMA(1, 1, At, B1); PG8_BAR; PG8_SCHED;
        }
        if constexpr (ALIGN_EPI) { if (wr == 0) PG8_BAR; }
        if constexpr (!Epi::AFTER_DRAIN) E(acc, cur, wr, wc, fr, fq);
        if (!has_next) break;
#pragma unroll
        for (int a = 0; a < 2; ++a)
#pragma unroll
            for (int b = 0; b < 2; ++b)
#pragma unroll
                for (int m = 0; m < 4; ++m)
#pragma unroll
                    for (int n = 0; n < 2; ++n) acc[a][b][m][n] = (f32x4){0.f, 0.f, 0.f, 0.f};
        cur = nxt; cA = nA; cB = nB; ++ui;
        if constexpr (ALIGN_EPI) { if (wr == 1) PG8_BAR; }
    }
    PG8_WAIT_V(0);
    if constexpr (!ALIGN_EPI) { if (wr == 0) PG8_BAR; }
    PG8_BAR;
    if constexpr (Epi::AFTER_DRAIN) E.fused(acc, cur, wr, wc, fr, fq, lds, wid, lane);
#undef PG8_SA
#undef PG8_SB
#undef PG8_STAGE
#undef PG8_LDA
#undef PG8_LDB
#undef PG8_MMA
#undef PG8_WAIT_V
#undef PG8_WAIT_L
#undef PG8_BAR
#undef PG8_SCHED
}
}

namespace att {
constexpr int QBLK = 32, KVBLK = 64;
constexpr float SCALE = 0.07216878364870322f;
constexpr float THR = 8.f;
constexpr int SHM_V = KVBLK * 128 * 2, SHM_K = KVBLK * 128 * 2, SHM_KR = KVBLK * 64 * 2;
constexpr int NSLOT = 3, OFF_V = 0, OFF_K = NSLOT * SHM_V, OFF_KR = OFF_K + NSLOT * SHM_K, OFF_WS = OFF_KR + NSLOT * SHM_KR, OFF_QR = OFF_WS + 2048;
#define KSWZ(row, colB) ((row) * 256 + ((colB) ^ (((row) & 7) << 4)))
#define KRSWZ(row, colB) ((row) * 128 + ((colB) ^ (((row) & 7) << 4)))
#define SBAR() __builtin_amdgcn_sched_barrier(0)
__device__ __forceinline__ int crow(int r, int hi) { return (r & 3) + 8 * (r >> 2) + 4 * hi; }
__device__ __forceinline__ void partialSM(f32x16& p0, f32x16& p1, float& m_reg, float& mn, float& alpha) {
  constexpr float C = SCALE * 1.4426950408889634f;
  float pmax = p0[0];
#pragma unroll
  for (int r = 1; r < 16; ++r) pmax = fmaxf(pmax, p0[r]);
#pragma unroll
  for (int r = 0; r < 16; ++r) pmax = fmaxf(pmax, p1[r]);
  { auto rr = __builtin_amdgcn_permlane32_swap(__float_as_uint(pmax), __float_as_uint(pmax), false, false);
    pmax = fmaxf(__uint_as_float(rr[0]), __uint_as_float(rr[1])); }
  if (__builtin_expect(__all(pmax - m_reg <= THR / SCALE), 1)) { mn = m_reg; alpha = 1.f; }
  else { mn = fmaxf(m_reg, pmax); alpha = __builtin_amdgcn_exp2f((m_reg - mn) * C); m_reg = mn; }
  float mnC = -mn * C;
#pragma unroll
  for (int r = 0; r < 16; ++r) p0[r] = fmaf(p0[r], C, mnC);
#pragma unroll
  for (int r = 0; r < 16; ++r) p1[r] = fmaf(p1[r], C, mnC);
#pragma unroll
  for (int r = 0; r < 16; ++r) p0[r] = __builtin_amdgcn_exp2f(p0[r]);
}
__device__ __forceinline__ void finishSM(f32x16& p0, f32x16& p1, float alpha, float& l_reg, bf16x8& pa0, bf16x8& pa1, bf16x8& pa2, bf16x8& pa3) {
#pragma unroll
  for (int r = 0; r < 16; ++r) p1[r] = __builtin_amdgcn_exp2f(p1[r]);
  float ps = 0;
#pragma unroll
  for (int r = 0; r < 16; ++r) ps += p0[r];
#pragma unroll
  for (int r = 0; r < 16; ++r) ps += p1[r];
  { auto rr = __builtin_amdgcn_permlane32_swap(__float_as_uint(ps), __float_as_uint(ps), false, false);
    ps = __uint_as_float(rr[0]) + __uint_as_float(rr[1]); }
  l_reg = l_reg * alpha + ps;
#define PK4(P, BASE, OUT) do { unsigned a0 = cvt_pk_bf16(P[BASE + 0], P[BASE + 1]), a1 = cvt_pk_bf16(P[BASE + 2], P[BASE + 3]);   \
    unsigned b0 = cvt_pk_bf16(P[BASE + 4], P[BASE + 5]), b1 = cvt_pk_bf16(P[BASE + 6], P[BASE + 7]);                              \
    auto r0 = __builtin_amdgcn_permlane32_swap(a0, b0, false, false); auto r1 = __builtin_amdgcn_permlane32_swap(a1, b1, false, false); \
    u32x4 w = {r0[0], r1[0], r0[1], r1[1]}; OUT = *reinterpret_cast<bf16x8*>(&w); } while (0)
  PK4(p0, 0, pa0); PK4(p0, 8, pa1); PK4(p1, 0, pa2); PK4(p1, 8, pa3);
#undef PK4
}
__device__ __forceinline__ void qkt(f32x16& p0, f32x16& p1, const LAS char* Ks, const LAS char* KRs, const bf16x8* qr, const LAS char* qrl, int r32, int hi) {
  p0 = f32x16{}; p1 = f32x16{};
#pragma unroll
  for (int d0 = 0; d0 < 8; ++d0) { const int cb = (d0 * 16 + hi * 8) * 2;
    bf16x8 b0 = *(const LAS bf16x8*)(Ks + KSWZ(r32, cb));
    bf16x8 b1 = *(const LAS bf16x8*)(Ks + KSWZ(32 + r32, cb));
    const bf16x8 qq = qr[d0];
    p0 = __builtin_amdgcn_mfma_f32_32x32x16_bf16(b0, qq, p0, 0, 0, 0);
    p1 = __builtin_amdgcn_mfma_f32_32x32x16_bf16(b1, qq, p1, 0, 0, 0); }
#pragma unroll
  for (int d0 = 0; d0 < 4; ++d0) { const int cb = (d0 * 16 + hi * 8) * 2;
    bf16x8 b0 = *(const LAS bf16x8*)(KRs + KRSWZ(r32, cb));
    bf16x8 b1 = *(const LAS bf16x8*)(KRs + KRSWZ(32 + r32, cb));
    const bf16x8 qq = *(const LAS bf16x8*)(qrl + d0 * 1024);
    p0 = __builtin_amdgcn_mfma_f32_32x32x16_bf16(b0, qq, p0, 0, 0, 0);
    p1 = __builtin_amdgcn_mfma_f32_32x32x16_bf16(b1, qq, p1, 0, 0, 0); }
}
__device__ __forceinline__ int v_st(int k, int c) { const int kk = (k & ~0xC) | ((k & 4) << 1) | ((k & 8) >> 1); return ((kk >> 3) * 4 + (c >> 5)) * 512 + ((kk & 7) * 32 + (c & 31)) * 2; }
__device__ __forceinline__ int v_rd_base(int lane) { return ((lane & 3) << 3) | (((lane >> 2) & 3) << 6) | (((lane >> 4) & 1) << 5) | (((lane >> 5) & 1) << 8); }
constexpr int v_rd_off(int d0, int ks, int half) { return d0 * 512 + ks * 4096 + half * 2048; }
template <int OFF> __device__ __forceinline__ s16x4 tr_read(int vb) {
  s16x4 r; asm volatile("ds_read_b64_tr_b16 %0, %1 offset:%2" : "=&v"(r) : "v"(vb), "i"(OFF) : "memory"); return r;
}
template <int D0> __device__ __forceinline__ void pv_one(f32x16& od, int vb, bf16x8 pa0, bf16x8 pa1, bf16x8 pa2, bf16x8 pa3) {
  const s16x4 l0 = tr_read<v_rd_off(D0, 0, 0)>(vb), h0 = tr_read<v_rd_off(D0, 0, 1)>(vb), l1 = tr_read<v_rd_off(D0, 1, 0)>(vb), h1 = tr_read<v_rd_off(D0, 1, 1)>(vb);
  const s16x4 l2 = tr_read<v_rd_off(D0, 2, 0)>(vb), h2 = tr_read<v_rd_off(D0, 2, 1)>(vb), l3 = tr_read<v_rd_off(D0, 3, 0)>(vb), h3 = tr_read<v_rd_off(D0, 3, 1)>(vb);
  asm volatile("s_waitcnt lgkmcnt(0)" ::: "memory"); SBAR();
#define PK(L, H) (bf16x8){L[0], L[1], L[2], L[3], H[0], H[1], H[2], H[3]}
  od = __builtin_amdgcn_mfma_f32_32x32x16_bf16(pa0, PK(l0, h0), od, 0, 0, 0);
  od = __builtin_amdgcn_mfma_f32_32x32x16_bf16(pa1, PK(l1, h1), od, 0, 0, 0);
  od = __builtin_amdgcn_mfma_f32_32x32x16_bf16(pa2, PK(l2, h2), od, 0, 0, 0);
  od = __builtin_amdgcn_mfma_f32_32x32x16_bf16(pa3, PK(l3, h3), od, 0, 0, 0);
#undef PK
}
__device__ __forceinline__ void pv_d0(f32x16* o, int vb, bf16x8 pa0, bf16x8 pa1, bf16x8 pa2, bf16x8 pa3) {
  pv_one<0>(o[0], vb, pa0, pa1, pa2, pa3); pv_one<1>(o[1], vb, pa0, pa1, pa2, pa3); pv_one<2>(o[2], vb, pa0, pa1, pa2, pa3); pv_one<3>(o[3], vb, pa0, pa1, pa2, pa3);
}

#define EX2(v) __builtin_amdgcn_exp2f(v)
#define PK4F(P, BASE, OUT) do { unsigned a0 = cvt_pk_bf16(P[BASE + 0], P[BASE + 1]), a1 = cvt_pk_bf16(P[BASE + 2], P[BASE + 3]);   \
    unsigned b0 = cvt_pk_bf16(P[BASE + 4], P[BASE + 5]), b1 = cvt_pk_bf16(P[BASE + 6], P[BASE + 7]);                              \
    auto r0 = __builtin_amdgcn_permlane32_swap(a0, b0, false, false); auto r1 = __builtin_amdgcn_permlane32_swap(a1, b1, false, false); \
    u32x4 w = {r0[0], r1[0], r0[1], r1[1]}; OUT = *reinterpret_cast<bf16x8*>(&w); } while (0)
__device__ __forceinline__ void qkt_fin(f32x16& c0, f32x16& c1, const LAS char* Ks, const LAS char* KRs, const bf16x8* qr, const LAS char* qrl, int r32, int hi,
                                        f32x16& p0, f32x16& p1, float alpha, float& l_reg, bf16x8& pa0, bf16x8& pa1, bf16x8& pa2, bf16x8& pa3) {
  c0 = f32x16{}; c1 = f32x16{};
  bf16x8 ka[3][2], qa[3]; float ps = 0.f;
#define KRD(D0) do { constexpr int s_ = (D0) % 3; if ((D0) < 8) { const int cb_ = ((D0) * 16 + hi * 8) * 2; \
      ka[s_][0] = *(const LAS bf16x8*)(Ks + KSWZ(r32, cb_)); ka[s_][1] = *(const LAS bf16x8*)(Ks + KSWZ(32 + r32, cb_)); } \
    else { const int cb_ = (((D0) - 8) * 16 + hi * 8) * 2; \
      ka[s_][0] = *(const LAS bf16x8*)(KRs + KRSWZ(r32, cb_)); ka[s_][1] = *(const LAS bf16x8*)(KRs + KRSWZ(32 + r32, cb_)); qa[s_] = *(const LAS bf16x8*)(qrl + ((D0) - 8) * 1024); } } while (0)
#define QMM(D0) do { constexpr int s_ = (D0) % 3; const bf16x8 qq_ = (D0) < 8 ? qr[(D0) & 7] : qa[s_]; \
    c0 = __builtin_amdgcn_mfma_f32_32x32x16_bf16(ka[s_][0], qq_, c0, 0, 0, 0); c1 = __builtin_amdgcn_mfma_f32_32x32x16_bf16(ka[s_][1], qq_, c1, 0, 0, 0); \
    if ((D0) + 3 < 12) { KRD((D0) + 3); } } while (0)
#define E2(K) do { p1[2 * (K)] = EX2(p1[2 * (K)]); p1[2 * (K) + 1] = EX2(p1[2 * (K) + 1]); } while (0)
#define SUM8(P, B) do { ps += ((P[B] + P[B + 1]) + (P[B + 2] + P[B + 3])) + ((P[B + 4] + P[B + 5]) + (P[B + 6] + P[B + 7])); } while (0)
  KRD(0); KRD(1); KRD(2); SBAR();
  QMM(0);  E2(0); PK4F(p0, 0, pa0); SBAR();
  QMM(1);  E2(1); PK4F(p0, 8, pa1); SBAR();
  QMM(2);  E2(2); SUM8(p0, 0); SBAR();
  QMM(3);  E2(3); SUM8(p0, 8); SBAR();
  QMM(4);  E2(4); SUM8(p1, 0); SBAR();
  QMM(5);  E2(5); PK4F(p1, 0, pa2); SBAR();
  QMM(6);  E2(6); SBAR();
  QMM(7);  E2(7); SBAR();
  QMM(8);  SUM8(p1, 8); SBAR();
  QMM(9);  PK4F(p1, 8, pa3); SBAR();
  QMM(10); { auto rr = __builtin_amdgcn_permlane32_swap(__float_as_uint(ps), __float_as_uint(ps), false, false); ps = __uint_as_float(rr[0]) + __uint_as_float(rr[1]); }
           l_reg = l_reg * alpha + ps; SBAR();
  QMM(11); SBAR();
#undef KRD
#undef QMM
#undef E2
#undef SUM8
}
__device__ __forceinline__ void pv_part(f32x16* o, int vb, bf16x8 pa0, bf16x8 pa1, bf16x8 pa2, bf16x8 pa3, f32x16& c0, f32x16& c1, float& m_reg, float& mn, float& alpha) {
  constexpr float C = SCALE * 1.4426950408889634f;
  s16x4 l0, h0, l1, h1, l2, h2, l3, h3;
#define VRD(D0) do { l0 = tr_read<v_rd_off(D0, 0, 0)>(vb); h0 = tr_read<v_rd_off(D0, 0, 1)>(vb); l1 = tr_read<v_rd_off(D0, 1, 0)>(vb); h1 = tr_read<v_rd_off(D0, 1, 1)>(vb); \
    l2 = tr_read<v_rd_off(D0, 2, 0)>(vb); h2 = tr_read<v_rd_off(D0, 2, 1)>(vb); l3 = tr_read<v_rd_off(D0, 3, 0)>(vb); h3 = tr_read<v_rd_off(D0, 3, 1)>(vb); } while (0)
#define PKV(L, H) (bf16x8){L[0], L[1], L[2], L[3], H[0], H[1], H[2], H[3]}
#define VMM(D0) do { asm volatile("s_waitcnt lgkmcnt(0)" ::: "memory"); SBAR(); \
    o[D0] = __builtin_amdgcn_mfma_f32_32x32x16_bf16(pa0, PKV(l0, h0), o[D0], 0, 0, 0); o[D0] = __builtin_amdgcn_mfma_f32_32x32x16_bf16(pa1, PKV(l1, h1), o[D0], 0, 0, 0); \
    o[D0] = __builtin_amdgcn_mfma_f32_32x32x16_bf16(pa2, PKV(l2, h2), o[D0], 0, 0, 0); o[D0] = __builtin_amdgcn_mfma_f32_32x32x16_bf16(pa3, PKV(l3, h3), o[D0], 0, 0, 0); SBAR(); } while (0)
  VRD(0);
  VMM(0); VRD(1);
  float mnC;
  { float pmax = c0[0];
#pragma unroll
    for (int r = 1; r < 16; ++r) pmax = fmaxf(pmax, c0[r]);
#pragma unroll
    for (int r = 0; r < 16; ++r) pmax = fmaxf(pmax, c1[r]);
    { auto rr = __builtin_amdgcn_permlane32_swap(__float_as_uint(pmax), __float_as_uint(pmax), false, false); pmax = fmaxf(__uint_as_float(rr[0]), __uint_as_float(rr[1])); }
    const bool need = !__all(pmax - m_reg <= THR / SCALE);
    mn = need ? fmaxf(m_reg, pmax) : m_reg; alpha = need ? EX2((m_reg - mn) * C) : 1.f; m_reg = mn; mnC = -mn * C; asm volatile("" : "+v"(mnC), "+v"(alpha)); }
  SBAR();
  VMM(1); VRD(2);
#pragma unroll
  for (int r = 0; r < 16; ++r) c0[r] = fmaf(c0[r], C, mnC);
#pragma unroll
  for (int r = 0; r < 8; ++r) c0[r] = EX2(c0[r]);
  asm volatile("" : "+v"(c0));
  SBAR();
  VMM(2); VRD(3);
#pragma unroll
  for (int r = 0; r < 16; ++r) c1[r] = fmaf(c1[r], C, mnC);
#pragma unroll
  for (int r = 8; r < 16; ++r) c0[r] = EX2(c0[r]);
  asm volatile("" : "+v"(c0), "+v"(c1));
  SBAR();
  VMM(3);
#undef VRD
#undef PKV
#undef VMM
}
__device__ __forceinline__ void attn_unit(int b, int h, int qb, const bf16_t* __restrict__ Q, const bf16_t* __restrict__ KV, const bf16_t* __restrict__ KR,
                                          const float* __restrict__ gmix, bf16_t* __restrict__ MIXN, LAS char* lds) {
  const int tid = otid(), wid = tid >> 6, lane = tid & 63, r32 = lane & 31, hi = lane >> 5;
  LAS char* V_lds = lds + OFF_V; LAS char* K_lds = lds + OFF_K; LAS char* KR_lds = lds + OFF_KR;
  LAS float* ws = (LAS float*)(lds + OFF_WS) + wid * 64; LAS float* li_l = ws; LAS float* al_l = ws + 32;
  float m_reg = -1e30f, l_reg = 0; f32x16 o[4] = {}; bf16x8 qr[8];
  LAS char* qrl = lds + OFF_QR + wid * 4096 + lane * 16;
  const long qrow0 = (long)b * SEQ + qb * 256 + wid * QBLK;
  const bf16_t* Qw = Q + (qrow0 + r32) * QW + h * DQK + hi * 8;
#pragma unroll
  for (int d0 = 0; d0 < 8; ++d0) qr[d0] = __builtin_nontemporal_load((const bf16x8*)(Qw + d0 * 16));
#pragma unroll
  for (int d0 = 0; d0 < 4; ++d0) *(LAS bf16x8*)(qrl + d0 * 1024) = *(const bf16x8*)(Qw + (8 + d0) * 16);
  const int wu = __builtin_amdgcn_readfirstlane(wid);
  const int vb0 = (int)(uintptr_t)V_lds + v_rd_base(lane);
  const bf16_t* Kh = KV + h * 256;
  unsigned offK[2], offV[2], offR;
#pragma unroll
  for (int i = 0; i < 2; ++i) { const int o = (wu * 2 + i) * 1024 + lane * 16;
    { const int row = o >> 8, cb = (o & 255) ^ ((row & 7) << 4); offK[i] = (unsigned)(row * KVW * 2 + cb); }
    { const int sub = o >> 9, kk = (sub >> 2) * 8 + ((o & 511) >> 6), col = (sub & 3) * 32 + ((o & 63) >> 1), key = (kk & ~0xC) | ((kk & 4) << 1) | ((kk & 8) >> 1);
      offV[i] = (unsigned)(key * KVW * 2 + col * 2 + 256); } }
  { const int o = wu * 1024 + lane * 16, row = o >> 7, cb = (o & 127) ^ ((row & 7) << 4); offR = (unsigned)(row * ROPE * 2 + cb); }
#define ROWB(j) ((j) < 32 ? (long)b * SEQ + (j) * 64 : (long)ML + b * CTXL + ((j) - 32) * 64)
#define DMA_TILE(j, slot) do { const long rb_ = ROWB(j); const char* kb_ = (const char*)(Kh + rb_ * KVW); const char* rbp_ = (const char*)(KR + rb_ * ROPE); \
    _Pragma("unroll") for (int i_ = 0; i_ < 2; ++i_) { \
      __builtin_amdgcn_global_load_lds((const unsigned*)(kb_ + offK[i_]), (LAS unsigned*)(K_lds + (slot) * SHM_K + (wu * 2 + i_) * 1024), 16, 0, 0); \
      __builtin_amdgcn_global_load_lds((const unsigned*)(kb_ + offV[i_]), (LAS unsigned*)(V_lds + (slot) * SHM_V + (wu * 2 + i_) * 1024), 16, 0, 0); } \
    __builtin_amdgcn_global_load_lds((const unsigned*)(rbp_ + offR), (LAS unsigned*)(KR_lds + (slot) * SHM_KR + wu * 1024), 16, 0, 0); } while (0)
#define DMA_WAIT() asm volatile("s_waitcnt vmcnt(0)" ::: "memory")
#define RESC(a) do { if (__any((a) < 1.f)) { if (hi == 0) al_l[r32] = (a); asm volatile("s_waitcnt lgkmcnt(0)" ::: "memory"); \
    _Pragma("unroll") for (int d = 0; d < 4; ++d) _Pragma("unroll") for (int r = 0; r < 16; ++r) o[d][r] *= al_l[crow(r, hi)]; } } while (0)
  f32x16 pA0, pA1, pB0, pB1; float mnA, mnB, alA, alB; bf16x8 pa0, pa1, pa2, pa3; constexpr int NT = 36;
  DMA_TILE(0, 0); DMA_TILE(1, 1); DMA_WAIT(); __syncthreads();
  qkt(pA0, pA1, K_lds, KR_lds, qr, qrl, r32, hi); partialSM(pA0, pA1, m_reg, mnA, alA);
  int sK = 1, sV = 0, sW = 2;
#define ITER(PC0, PC1, mnC, alC, PP0, PP1, alP, jj, DOLOAD) do { \
    if (DOLOAD) { DMA_TILE((jj) + 1, sW); } \
    SBAR(); qkt_fin(PC0, PC1, K_lds + sK * SHM_K, KR_lds + sK * SHM_KR, qr, qrl, r32, hi, PP0, PP1, alP, l_reg, pa0, pa1, pa2, pa3); SBAR(); \
    pv_part(o, vb0 + sV * SHM_V, pa0, pa1, pa2, pa3, PC0, PC1, m_reg, mnC, alC); \
    RESC(alC); DMA_WAIT(); __syncthreads(); \
    { const int t_ = sV; sV = sK; sK = sW; sW = t_; } } while (0)
  for (int j = 1; j + 1 < NT; j += 2) {
    ITER(pB0, pB1, mnB, alB, pA0, pA1, alA, j, true);
    ITER(pA0, pA1, mnA, alA, pB0, pB1, alB, j + 1, true);
  }
  ITER(pB0, pB1, mnB, alB, pA0, pA1, alA, NT - 1, false);
  finishSM(pB0, pB1, alB, l_reg, pa0, pa1, pa2, pa3); SBAR();
  pv_d0(o, vb0 + sV * SHM_V, pa0, pa1, pa2, pa3);
#undef ITER
  if (hi == 0) li_l[r32] = l_reg; asm volatile("s_waitcnt lgkmcnt(0)" ::: "memory");
  float rli[16];
#pragma unroll
  for (int r = 0; r < 16; ++r) rli[r] = __builtin_amdgcn_rcpf(li_l[crow(r, hi)]);
  __syncthreads();
  constexpr int OST = 132;
  LAS float* st = (LAS float*)lds + wid * (32 * OST);
#pragma unroll
  for (int r = 0; r < 16; ++r) { const int orow = crow(r, hi);
#pragma unroll
    for (int d0 = 0; d0 < 4; ++d0) st[orow * OST + d0 * 32 + r32] = o[d0][r] * rli[r]; }
  asm volatile("s_waitcnt lgkmcnt(0)" ::: "memory");
  { int lane2 = lane; asm volatile("" : "+v"(lane2));
    const int row = lane2 >> 1, half = lane2 & 1; const LAS float* rp = st + row * OST + half * 64;
    f32x4 v[16]; float ss = 0.f;
#pragma unroll
    for (int i = 0; i < 16; ++i) { v[i] = *(const LAS f32x4*)(rp + 4 * i); ss += (v[i][0] * v[i][0] + v[i][1] * v[i][1]) + (v[i][2] * v[i][2] + v[i][3] * v[i][3]); }
    ss += __shfl_xor(ss, 1);
    const float rs = rsqrtf(ss * (1.0f / 128.0f) + EPS);
    const float* gp = gmix + h * 128 + half * 64;
    bf16_t* op = MIXN + (qrow0 + row) * DM + h * 128 + half * 64;
#pragma unroll
    for (int i = 0; i < 8; ++i) { const f32x4 g0 = *(const f32x4*)(gp + 8 * i), g1 = *(const f32x4*)(gp + 8 * i + 4); const f32x4 a = v[2 * i] * rs * g0, c = v[2 * i + 1] * rs * g1;
      u32x4 w; w.x = cvt_pk_bf16(a[0], a[1]); w.y = cvt_pk_bf16(a[2], a[3]); w.z = cvt_pk_bf16(c[0], c[1]); w.w = cvt_pk_bf16(c[2], c[3]);
      *(u32x4*)(op + 8 * i) = w; } }
  asm volatile("s_waitcnt lgkmcnt(0)" ::: "memory");
  __syncthreads();
#undef ROWB
#undef DMA_TILE
#undef DMA_WAIT
#undef RESC
}
#undef SBAR
}

struct Params {
    const float *x, *c, *ctx, *c_ctx, *w_ada, *b_ada, *g_mix_norm, *w_in, *g_q_a, *w_q_b, *g_kv_a, *w_kv_b,
                *conv_w, *conv_b, *g_mix_out, *w_out, *g_ffn_norm, *w_up, *ffn_conv_w, *ffn_conv_b, *w_down, *g_final;
    float* out; unsigned char* ws;
};

__device__ __forceinline__ unsigned f2bf(float f) { unsigned u = __float_as_uint(f); return (u + 0x7fffu + ((u >> 16) & 1u)) >> 16; }
__device__ __forceinline__ unsigned pk2(float lo, float hi) { return f2bf(lo) | (f2bf(hi) << 16); }
__device__ __forceinline__ void p0_transpose_item(const float* W, int K, int N, bf16_t* WT, LAS float* scr, int item, int lane, bool upmap = false) {
    const int nblk = N / 64, kb = item / nblk, nb = item % nblk, k0 = 64 * kb, n0 = 64 * nb;
    const int n0o = !upmap ? n0 : (n0 < FFN ? (n0 >> 7) * 256 + (n0 & 127) : ((n0 - FFN) >> 7) * 256 + 128 + ((n0 - FFN) & 127));
    const int lr = lane >> 4, lc = (lane & 15) * 4;
    const float* wp = W + (size_t)(k0 + lr) * N + n0 + lc;
    f32x4 v[16];
#pragma unroll
    for (int i = 0; i < 16; ++i) v[i] = __builtin_nontemporal_load((const f32x4*)(wp + (size_t)(4 * i) * N));
#pragma unroll
    for (int i = 0; i < 16; ++i) { LAS float* d = scr + (4 * i + lr) * 65 + lc; d[0] = v[i][0]; d[1] = v[i][1]; d[2] = v[i][2]; d[3] = v[i][3]; }
    asm volatile("s_waitcnt lgkmcnt(0)" ::: "memory");
    const int c = lane & 7;
#pragma unroll
    for (int j = 0; j < 8; ++j) { const int n = (lane >> 3) + 8 * j; const LAS float* s = scr + (8 * c) * 65 + n;
        u32x4 o; o.x = cvt_pk_bf16(s[0 * 65], s[1 * 65]); o.y = cvt_pk_bf16(s[2 * 65], s[3 * 65]); o.z = cvt_pk_bf16(s[4 * 65], s[5 * 65]); o.w = cvt_pk_bf16(s[6 * 65], s[7 * 65]);
        if (upmap) __builtin_nontemporal_store(o, (u32x4*)(WT + (size_t)(n0o + n) * K + k0 + 8 * c)); else *(u32x4*)(WT + (size_t)(n0o + n) * K + k0 + 8 * c) = o; }
    asm volatile("s_waitcnt lgkmcnt(0)" ::: "memory");
}
constexpr int I_IN = 32 * (INC / 64), I_QB = (QRANK / 64) * (QW / 64), I_KVB = (KVRANK / 64) * (KVW / 64), I_OUT = 32 * (DM / 64), I_UP = 32 * (FFN2 / 64), I_DOWN = (FFN / 64) * (DM / 64);
constexpr int I_TOTAL = I_IN + I_QB + I_KVB + I_OUT + I_UP + I_DOWN;
constexpr int I_P0 = I_TOTAL - I_DOWN;
__device__ __forceinline__ void p0_item(const Params& p, int it, LAS float* scr, int lane) {
    unsigned char* ws = p.ws; int r = it;
    if (r < I_UP) { p0_transpose_item(p.w_up, DM, FFN2, (bf16_t*)(ws + WS_WUP), scr, r, lane, true); return; } r -= I_UP;
    if (r < I_IN) { p0_transpose_item(p.w_in, DM, INC, (bf16_t*)(ws + WS_WIN), scr, r, lane); return; } r -= I_IN;
    if (r < I_OUT) { p0_transpose_item(p.w_out, DM, DM, (bf16_t*)(ws + WS_WOUT), scr, r, lane); return; } r -= I_OUT;
    if (r < I_QB) { p0_transpose_item(p.w_q_b, QRANK, QW, (bf16_t*)(ws + WS_WQB), scr, r, lane); return; } r -= I_QB;
    p0_transpose_item(p.w_kv_b, KVRANK, KVW, (bf16_t*)(ws + WS_WKVB), scr, r, lane);
}
__device__ __forceinline__ void phase_prologue(const Params& p, LAS unsigned char* lds, int G) {
    const int tid = otid(), lane = tid & 63, wave = __builtin_amdgcn_readfirstlane(tid >> 6), blk = blockIdx.x;
    const int gw = blk * NWAVES + wave, NGW = G * NWAVES, gtid = blk * NTHR + tid, NGT = G * NTHR;
    unsigned char* ws = p.ws;
    for (int idx = gtid; idx < SEQ * 32; idx += NGT) { const int t = idx >> 5, i = idx & 31; const float pos = (float)((i < 16) ? (t >> 6) : (t & 63));
        const float inv = exp2f(-(float)(i & 15) * (13.287712379549449f / 16.0f)); const float ang = pos * inv;
        ((f32x2*)(ws + WS_ROPE))[idx] = (f32x2){cosf(ang), sinf(ang)}; }
    for (int i = gtid; i < (INP - INC) * DM / 8; i += NGT) ((u32x4*)((bf16_t*)(ws + WS_WIN) + (size_t)INC * DM))[i] = (u32x4){0u, 0u, 0u, 0u};
    const int NGEMV = 192 < G ? 192 : 0;
    if (blk < NGEMV) {
        const int nc = blk % 48, ksc = blk / 48, k0 = ksc * 512 + wave * 64;
        float sv[5];
#pragma unroll
        for (int r = 0; r < 5; ++r) { const float cvv = (r < 4) ? p.c[r * DM + k0 + lane] : p.c_ctx[k0 + lane]; sv[r] = silu_f(cvv); }
        f32x4 acc[5];
#pragma unroll
        for (int r = 0; r < 5; ++r) acc[r] = (f32x4){0.f, 0.f, 0.f, 0.f};
        const float* wp = p.w_ada + (size_t)k0 * 12288 + nc * 256 + 4 * lane;
#pragma unroll 16
        for (int kk = 0; kk < 64; ++kk) { const f32x4 wv = __builtin_nontemporal_load((const f32x4*)(wp + (size_t)kk * 12288));
#pragma unroll
            for (int r = 0; r < 5; ++r) { const float s = __uint_as_float(__builtin_amdgcn_readlane(__float_as_uint(sv[r]), kk)); acc[r] += wv * s; } }
        LAS float* red = (LAS float*)lds;
#pragma unroll
        for (int r = 0; r < 5; ++r)
#pragma unroll
            for (int j = 0; j < 4; ++j) red[(wave * 20 + r * 4 + j) * 64 + lane] = acc[r][j];
        __syncthreads();
        float* mod = (float*)(ws + WS_MOD);
        for (int o = tid; o < 1280; o += NTHR) { const int r = o >> 8, col = o & 255, l = col >> 2, j = col & 3; float s = 0.f;
#pragma unroll
            for (int w = 0; w < 8; ++w) s += red[(w * 20 + r * 4 + j) * 64 + l];
            if (ksc == 0) s += p.b_ada[nc * 256 + col];
            __hip_atomic_fetch_add(mod + r * 12288 + nc * 256 + col, s, __ATOMIC_RELAXED, __HIP_MEMORY_SCOPE_AGENT); }
        asm volatile("s_waitcnt vmcnt(0)" ::: "memory");
        __syncthreads();
        if (tid == 0) __hip_atomic_fetch_add((unsigned*)(ws + WS_MODCNT), 1u, __ATOMIC_RELEASE, __HIP_MEMORY_SCOPE_AGENT);
    }
    LAS float* scr = (LAS float*)(lds + wave * 16640);
    const int nfree = (G - NGEMV) * NWAVES; int head = nfree * 4; if (head > I_P0) head = I_P0;
    if (blk >= NGEMV) { const int fw = (blk - NGEMV) * NWAVES + wave;
        for (int i = 0; i < 4; ++i) { const int it = fw * 4 + i; if (it < head) p0_item(p, it, scr, lane); } }
    for (int it = head + gw; it < I_P0; it += NGW) p0_item(p, it, scr, lane);
}

__device__ __forceinline__ void phase_normmod(const float* xl, const float* xc, const float* g, const float* mod, int sh_chunk, bf16_t* H, int nrows, int G) {
    const int tid = otid(), lane = tid & 63, wave = tid >> 6; const int gw = blockIdx.x * NWAVES + wave, NGW = G * NWAVES;
    for (int row = gw; row < nrows; row += NGW) {
        const float* xr = row < ML ? xl + (size_t)row * DM : xc + (size_t)(row - ML) * DM;
        const int mr = row < ML ? (row >> 11) : 4;
        const f32x4* shp = (const f32x4*)(mod + (size_t)mr * 12288 + sh_chunk * DM); const f32x4* scp = shp + DM / 4; const f32x4* gp = (const f32x4*)g;
        f32x4 v[8]; float ss = 0.f;
#pragma unroll
        for (int j = 0; j < 8; ++j) { v[j] = __builtin_nontemporal_load((const f32x4*)xr + lane + 64 * j); ss += (v[j][0] * v[j][0] + v[j][1] * v[j][1]) + (v[j][2] * v[j][2] + v[j][3] * v[j][3]); }
        ss = wave_sum(ss); const float rstd = rsqrtf(ss * (1.0f / DM) + EPS);
        u32x2* op = (u32x2*)(H + (size_t)row * DM);
#pragma unroll
        for (int j = 0; j < 8; ++j) { const f32x4 gg = gp[lane + 64 * j], s4 = scp[lane + 64 * j], h4 = shp[lane + 64 * j];
            const f32x4 y = v[j] * rstd * gg * (s4 + 1.0f) + h4; u32x2 w; w.x = cvt_pk_bf16(y[0], y[1]); w.y = cvt_pk_bf16(y[2], y[3]); op[lane + 64 * j] = w; }
    }
}
__device__ __forceinline__ void phase_final(float* xio, const float* g, int G) {
    const int tid = otid(), lane = tid & 63, wave = tid >> 6; const int gw = blockIdx.x * NWAVES + wave, NGW = G * NWAVES;
    for (int row = gw; row < ML; row += NGW) {
        f32x4* xr = (f32x4*)(xio + (size_t)row * DM); const f32x4* gp = (const f32x4*)g;
        f32x4 v[8]; float ss = 0.f;
#pragma unroll
        for (int j = 0; j < 8; ++j) { v[j] = xr[lane + 64 * j]; ss += (v[j][0] * v[j][0] + v[j][1] * v[j][1]) + (v[j][2] * v[j][2] + v[j][3] * v[j][3]); }
        ss = wave_sum(ss); const float rstd = rsqrtf(ss * (1.0f / DM) + EPS);
#pragma unroll
        for (int j = 0; j < 8; ++j) xr[lane + 64 * j] = v[j] * rstd * gp[lane + 64 * j];
    }
}

__device__ __forceinline__ void phase_prep(const Params& p, int G) {
    const int tid = otid(), lane = tid & 63, wave = tid >> 6; const int gw = blockIdx.x * NWAVES + wave, NGW = G * NWAVES;
    unsigned char* ws = p.ws;
    const bf16_t* P = (const bf16_t*)(ws + WS_P); bf16_t* QN = (bf16_t*)(ws + WS_QN); bf16_t* KVN = (bf16_t*)(ws + WS_KVN); bf16_t* KR = (bf16_t*)(ws + WS_KR); bf16_t* MIXN = (bf16_t*)(ws + WS_MIXN);
    const f32x2* tab = (const f32x2*)(ws + WS_ROPE);
    const float* SL = (const float*)(ws + WS_SLAB);
    for (int row = gw; row < MT; row += NGW) {
        const bf16_t* pr = P + (size_t)row * INP; const bool latent = row < ML;
        if (latent) { float f[8]; unpack8(*(const u32x4*)(pr + C_QA + 8 * lane), f); float ss = 0.f;
#pragma unroll
            for (int i = 0; i < 8; ++i) ss += f[i] * f[i];
            ss = wave_sum(ss); const float rs = rsqrtf(ss * (1.0f / QRANK) + EPS);
            const f32x4 g0 = *(const f32x4*)(p.g_q_a + 8 * lane), g1 = *(const f32x4*)(p.g_q_a + 8 * lane + 4);
#pragma unroll
            for (int i = 0; i < 4; ++i) { f[i] *= rs * g0[i]; f[4 + i] *= rs * g1[i]; }
            *(u32x4*)(QN + (size_t)row * QRANK + 8 * lane) = pack8(f); }
        float f[8];
#pragma unroll
        for (int i = 0; i < 8; ++i) f[i] = 0.f;
        if (lane < 40) {
            if (latent) unpack8(*(const u32x4*)(pr + C_KVA + 8 * lane), f);
            else { const float* sp = SL + (size_t)(row - ML) * 512 + 8 * lane;
#pragma unroll
                for (int k = 0; k < 8; ++k) { const f32x4 a = *(const f32x4*)(sp + (size_t)k * (1024 * 512)), b = *(const f32x4*)(sp + (size_t)k * (1024 * 512) + 4);
#pragma unroll
                    for (int i = 0; i < 4; ++i) { f[i] += a[i]; f[4 + i] += b[i]; } } } }
        float ss = 0.f;
        if (lane < 32) {
#pragma unroll
            for (int i = 0; i < 8; ++i) ss += f[i] * f[i]; }
        ss = wave_sum(ss); const float rs = rsqrtf(ss * (1.0f / KVRANK) + EPS);
        if (lane < 32) { const f32x4 g0 = *(const f32x4*)(p.g_kv_a + 8 * lane), g1 = *(const f32x4*)(p.g_kv_a + 8 * lane + 4);
#pragma unroll
            for (int i = 0; i < 4; ++i) { f[i] *= rs * g0[i]; f[4 + i] *= rs * g1[i]; }
            *(u32x4*)(KVN + (size_t)row * KVRANK + 8 * lane) = pack8(f); }
        else if (lane < 40) { const int l8 = lane - 32;
            if (latent) { const f32x2* tp = tab + (size_t)(row & (SEQ - 1)) * 32 + 4 * l8;
#pragma unroll
                for (int q = 0; q < 4; ++q) { const f32x2 cs = tp[q]; const float a = f[2 * q], b = f[2 * q + 1]; f[2 * q] = a * cs[0] - b * cs[1]; f[2 * q + 1] = a * cs[1] + b * cs[0]; } }
            *(u32x4*)(KR + (size_t)row * ROPE + 8 * l8) = pack8(f); }
    }
    for (int task = gw; task < ML / 4; task += NGW) {
        const int r0 = task * 4;
        float w0[2][8], w1[2][8], w2[2][8], bb[2][8], gg[2][8];
#pragma unroll
        for (int j = 0; j < 2; ++j) { const int ch = 8 * lane + 512 * j;
#pragma unroll
            for (int h = 0; h < 2; ++h) { const f32x4 a = *(const f32x4*)(p.conv_w + ch + 4 * h), b = *(const f32x4*)(p.conv_w + CONVW + ch + 4 * h), c = *(const f32x4*)(p.conv_w + 2 * CONVW + ch + 4 * h),
                    d = *(const f32x4*)(p.conv_b + ch + 4 * h), e = *(const f32x4*)(p.g_mix_out + 1024 + ch + 4 * h);
#pragma unroll
                for (int i = 0; i < 4; ++i) { w0[j][4 * h + i] = a[i]; w1[j][4 * h + i] = b[i]; w2[j][4 * h + i] = c[i]; bb[j][4 * h + i] = d[i]; gg[j][4 * h + i] = e[i]; } } }
        float zp[2][8], zc[2][8], zn[2][8];
#define ZLOAD(dst, row_, valid_) do { _Pragma("unroll") for (int j = 0; j < 2; ++j) { const int ch = 8 * lane + 512 * j; \
            if (valid_) { float a_[8], b_[8]; unpack8(*(const u32x4*)(P + (size_t)(row_) * INP + C_CC + ch), a_); unpack8(*(const u32x4*)(P + (size_t)(row_) * INP + C_CH + ch), b_); \
                _Pragma("unroll") for (int i = 0; i < 8; ++i) dst[j][i] = a_[i] * b_[i]; } \
            else { _Pragma("unroll") for (int i = 0; i < 8; ++i) dst[j][i] = 0.f; } } } while (0)
        ZLOAD(zp, r0 - 1, ((r0 & (SEQ - 1)) != 0));
        ZLOAD(zc, r0, true);
#pragma unroll
        for (int ii = 0; ii < 4; ++ii) { const int t = r0 + ii;
            ZLOAD(zn, t + 1, ((t & (SEQ - 1)) != SEQ - 1));
#pragma unroll
            for (int j = 0; j < 2; ++j) { const int ch = 8 * lane + 512 * j; float cbv[8], y[8]; unpack8(*(const u32x4*)(P + (size_t)t * INP + C_CB + ch), cbv); float ss = 0.f;
#pragma unroll
                for (int i = 0; i < 8; ++i) { y[i] = cbv[i] * (w0[j][i] * zp[j][i] + w1[j][i] * zc[j][i] + w2[j][i] * zn[j][i] + bb[j][i]); ss += y[i] * y[i]; }
                ss += __shfl_xor(ss, 1); ss += __shfl_xor(ss, 2); ss += __shfl_xor(ss, 4); ss += __shfl_xor(ss, 8);
                const float rs = rsqrtf(ss * (1.0f / 128.0f) + EPS);
#pragma unroll
                for (int i = 0; i < 8; ++i) y[i] *= rs * gg[j][i];
                *(u32x4*)(MIXN + (size_t)t * DM + 1024 + ch) = pack8(y); }
#pragma unroll
            for (int j = 0; j < 2; ++j)
#pragma unroll
                for (int i = 0; i < 8; ++i) { zp[j][i] = zc[j][i]; zc[j][i] = zn[j][i]; } }
#undef ZLOAD
    }
}

__device__ __forceinline__ void phase_act(const Params& p, int G) {
    const int gtid = blockIdx.x * NTHR + otid(), NGT = G * NTHR;
    const bf16_t* U = (const bf16_t*)(p.ws + WS_U); bf16_t* ACT = (bf16_t*)(p.ws + WS_ACT);
    constexpr int NCH = FFN / 8, RB = 16, NTASK = (ML / RB) * NCH;
    for (int task = gtid; task < NTASK; task += NGT) {
        const int chunk = task % NCH, r0 = (task / NCH) * RB, col = chunk * 8;
        float wa[3][8], wg[3][8], ba[8], bg[8];
#pragma unroll
        for (int k = 0; k < 3; ++k)
#pragma unroll
            for (int h = 0; h < 2; ++h) { const f32x4 a = *(const f32x4*)(p.ffn_conv_w + (size_t)k * FFN2 + col + 4 * h), g = *(const f32x4*)(p.ffn_conv_w + (size_t)k * FFN2 + FFN + col + 4 * h);
#pragma unroll
                for (int i = 0; i < 4; ++i) { wa[k][4 * h + i] = a[i]; wg[k][4 * h + i] = g[i]; } }
#pragma unroll
        for (int h = 0; h < 2; ++h) { const f32x4 a = *(const f32x4*)(p.ffn_conv_b + col + 4 * h), g = *(const f32x4*)(p.ffn_conv_b + FFN + col + 4 * h);
#pragma unroll
            for (int i = 0; i < 4; ++i) { ba[4 * h + i] = a[i]; bg[4 * h + i] = g[i]; } }
        float pa[8], pg[8], ca[8], cgv[8], na[8], ng[8];
#define ULOAD(da, dg, row_, valid_) do { if (valid_) { unpack8(*(const u32x4*)(U + (size_t)(row_) * FFN2 + col), da); unpack8(*(const u32x4*)(U + (size_t)(row_) * FFN2 + FFN + col), dg); } \
            else { _Pragma("unroll") for (int i = 0; i < 8; ++i) { da[i] = 0.f; dg[i] = 0.f; } } } while (0)
        ULOAD(pa, pg, r0 - 1, ((r0 & (SEQ - 1)) != 0));
        ULOAD(ca, cgv, r0, true);
#pragma unroll 4
        for (int ii = 0; ii < RB; ++ii) { const int t = r0 + ii;
            ULOAD(na, ng, t + 1, ((t & (SEQ - 1)) != SEQ - 1));
            float y[8];
#pragma unroll
            for (int i = 0; i < 8; ++i) { const float a = wa[0][i] * pa[i] + wa[1][i] * ca[i] + wa[2][i] * na[i] + ba[i]; const float g = wg[0][i] * pg[i] + wg[1][i] * cgv[i] + wg[2][i] * ng[i] + bg[i];
                y[i] = a * silu_f(g); }
            *(u32x4*)(ACT + (size_t)t * FFN + col) = pack8(y);
#pragma unroll
            for (int i = 0; i < 8; ++i) { pa[i] = ca[i]; pg[i] = cgv[i]; ca[i] = na[i]; cgv[i] = ng[i]; } }
#undef ULOAD
    }
}

__device__ __forceinline__ void act_fixup_panel(const Params& p, int pm) {
    const bf16_t* RAW = (const bf16_t*)(p.ws + WS_RAW); bf16_t* ACT = (bf16_t*)(p.ws + WS_ACT);
    constexpr int NCH = FFN / 8;
    for (int chunk = otid(); chunk < NCH; chunk += NTHR) {
        const int col = chunk * 8, tcol = (col >> 7) * 256 + (col & 127);
        float wa[3][8], wg[3][8], ba[8], bg[8];
#pragma unroll
        for (int h = 0; h < 2; ++h) {
#pragma unroll
            for (int k = 0; k < 3; ++k) { const f32x4 a = *(const f32x4*)(p.ffn_conv_w + (size_t)k * FFN2 + col + 4 * h), g = *(const f32x4*)(p.ffn_conv_w + (size_t)k * FFN2 + FFN + col + 4 * h);
#pragma unroll
                for (int i = 0; i < 4; ++i) { wa[k][4 * h + i] = a[i]; wg[k][4 * h + i] = g[i]; } }
            const f32x4 a = *(const f32x4*)(p.ffn_conv_b + col + 4 * h), g = *(const f32x4*)(p.ffn_conv_b + FFN + col + 4 * h);
#pragma unroll
            for (int i = 0; i < 4; ++i) { ba[4 * h + i] = a[i]; bg[4 * h + i] = g[i]; } }
#pragma unroll 2
        for (int rr = 0; rr < 8; ++rr) {
            const int rb = pm * 4 + (rr >> 1), bot = rr & 1, t = rb * 64 + (bot ? 63 : 0);
            const bool has_up = bot || ((rb & 31) != 0), has_dn = !bot || ((rb & 31) != 31);
            const size_t r_up = bot ? (size_t)rb * 4 + 2 : (size_t)(rb - 1) * 4 + 3, r_cu = (size_t)rb * 4 + (bot ? 3 : 0), r_dn = bot ? (size_t)(rb + 1) * 4 + 0 : (size_t)rb * 4 + 1;
            float ua[8], ug[8], ca[8], cg[8], da[8], dg[8];
            if (has_up) { unpack8(*(const u32x4*)(RAW + r_up * FFN2 + tcol), ua); unpack8(*(const u32x4*)(RAW + r_up * FFN2 + tcol + 128), ug); }
            else {
#pragma unroll
                for (int i = 0; i < 8; ++i) { ua[i] = 0.f; ug[i] = 0.f; } }
            unpack8(*(const u32x4*)(RAW + r_cu * FFN2 + tcol), ca); unpack8(*(const u32x4*)(RAW + r_cu * FFN2 + tcol + 128), cg);
            if (has_dn) { unpack8(*(const u32x4*)(RAW + r_dn * FFN2 + tcol), da); unpack8(*(const u32x4*)(RAW + r_dn * FFN2 + tcol + 128), dg); }
            else {
#pragma unroll
                for (int i = 0; i < 8; ++i) { da[i] = 0.f; dg[i] = 0.f; } }
            float y[8];
#pragma unroll
            for (int k = 0; k < 8; ++k) { const float a = wa[0][k] * ua[k] + wa[1][k] * ca[k] + wa[2][k] * da[k] + ba[k]; const float g = wg[0][k] * ug[k] + wg[1][k] * cg[k] + wg[2][k] * dg[k] + bg[k];
                y[k] = a * silu_f(g); }
            *(u32x4*)(ACT + (size_t)t * FFN + col) = pack8(y);
        }
    }
}

#define XB_TMO      128
#define XB_XCNT(j)  (256  + 64 * (j))
#define XB_XSUB(j)  (1280 + 64 * (j))
#define XB_XGEN(j)  (2304 + 64 * (j))
#define XB_TOP      3328
#define XB_TOPGEN   3392
#define XCD_BAR_WORDS 3456
#define XB_SPIN_CAP (1u << 18)
__device__ __forceinline__ unsigned xb_ld(unsigned* p)              { return __hip_atomic_load(p, __ATOMIC_RELAXED, __HIP_MEMORY_SCOPE_AGENT); }
__device__ __forceinline__ unsigned xb_add(unsigned* p, unsigned v) { return __hip_atomic_fetch_add(p, v, __ATOMIC_RELAXED, __HIP_MEMORY_SCOPE_AGENT); }
__device__ __forceinline__ unsigned xb_xcc_id() { return (unsigned)__builtin_amdgcn_s_getreg((3 << 11) | 20) & 0xFu; }
#define XB_SPIN(cond, bar) do { unsigned _sp = 0; while (cond) { __builtin_amdgcn_s_sleep(1); \
    if ((++_sp & 255u) == 0u) { if (xb_ld(&(bar)[XB_TMO])) break; if (_sp > XB_SPIN_CAP) { atomicAdd(&(bar)[XB_TMO], 1u); break; } } } } while (0)
struct XcdBarrier { unsigned* bar; unsigned x; volatile LAS unsigned* st; };
__device__ __forceinline__ XcdBarrier xcd_barrier_post(unsigned* bar, volatile LAS unsigned* st) {
    XcdBarrier b; b.bar = bar; b.x = xb_xcc_id(); b.st = st;
    if (threadIdx.x == 0) (void)xb_add(&bar[XB_XCNT(b.x)], 1u);
    return b;
}
__device__ __forceinline__ void xcd_barrier_complete(unsigned* bar, unsigned x, unsigned& nloc, unsigned& nx) {
    const unsigned G = gridDim.x * gridDim.y * gridDim.z;
    unsigned sum, cnt, mine, sp = 0u;
    for (;;) {
        sum = 0u; cnt = 0u; mine = 0u;
#pragma unroll
        for (unsigned j = 0; j < 16; ++j) { const unsigned c = xb_ld(&bar[XB_XCNT(j)]); sum += c; cnt += (c > 0u) ? 1u : 0u; mine = (j == x) ? c : mine; }
        if (sum == G) break;
        __builtin_amdgcn_s_sleep(1);
        if ((++sp & 255u) == 0u) { if (xb_ld(&bar[XB_TMO])) break; if (sp > XB_SPIN_CAP) { atomicAdd(&bar[XB_TMO], 1u); break; } }
    }
    nloc = mine > 0u ? mine : 1u; nx = cnt > 0u ? cnt : 1u;
}
__device__ __forceinline__ void xcd_barrier(const XcdBarrier& b) {
    asm volatile("s_waitcnt vmcnt(0)" ::: "memory");
    __syncthreads();
    if (threadIdx.x == 0) {
        unsigned* bar = b.bar;
        __builtin_amdgcn_s_waitcnt(0);
        unsigned nloc = b.st[0], nx = b.st[1];
        if (nloc == 0u) { xcd_barrier_complete(bar, b.x, nloc, nx); b.st[0] = nloc; b.st[1] = nx; }
        const unsigned old = xb_add(&bar[XB_XSUB(b.x)], 1u);
        const unsigned gen = old / nloc;
        if (old + 1u == (gen + 1u) * nloc) {
            __builtin_amdgcn_fence(__ATOMIC_RELEASE, "agent");
            asm volatile("s_waitcnt vmcnt(0)" ::: "memory");
            const unsigned og = xb_add(&bar[XB_TOP], 1u);
            const unsigned tg = og / nx;
            if (og + 1u == (tg + 1u) * nx) xb_add(&bar[XB_TOPGEN], 1u);
            else XB_SPIN(xb_ld(&bar[XB_TOPGEN]) == tg, bar);
            __builtin_amdgcn_fence(__ATOMIC_ACQUIRE, "agent");
            xb_add(&bar[XB_XGEN(b.x)], 1u);
            asm volatile("s_waitcnt vmcnt(0)" ::: "memory");
        } else {
            XB_SPIN(xb_ld(&bar[XB_XGEN(b.x)]) == gen, bar);
            __builtin_amdgcn_fence(__ATOMIC_ACQUIRE, "agent");
            asm volatile("s_waitcnt vmcnt(0)" ::: "memory");
        }
    }
    __syncthreads();
}

#ifndef PH_MASK
#define PH_MASK 0xfff
#endif
#define PH(k) ((PH_MASK >> (k)) & 1)
__global__ void __launch_bounds__(NTHR, 2) fwd_megakernel(Params p) {
    extern __shared__ __attribute__((aligned(16))) unsigned char lds_raw[];
    LAS unsigned char* lds = (LAS unsigned char*)lds_raw;
    cg::grid_group grid = cg::this_grid();
    const int G = gridDim.x, blk = blockIdx.x;
    unsigned char* ws = p.ws;
    float* mod = (float*)(ws + WS_MOD);
    volatile LAS unsigned* misc = (volatile LAS unsigned*)(lds + LDS_BYTES - 64);
    if (threadIdx.x < 16) misc[threadIdx.x] = 0u;
    __syncthreads();
    const XcdBarrier xbar = xcd_barrier_post((unsigned*)(ws + WS_BAR), misc);
#define SEAM() xcd_barrier(xbar)

    if (PH(0)) phase_prologue(p, lds, G);
    if (p.ws == nullptr) grid.sync();
    { const int tw = otid();
      if (tw < 64) { unsigned sp = 0; const unsigned want = (G > 192) ? 192u : 0u;
        while ((unsigned)__builtin_amdgcn_readfirstlane(__hip_atomic_load((unsigned*)(ws + WS_MODCNT), __ATOMIC_RELAXED, __HIP_MEMORY_SCOPE_AGENT)) < want) { __builtin_amdgcn_s_sleep(2); if (++sp > (1u << 20)) break; }
        __builtin_amdgcn_fence(__ATOMIC_ACQUIRE, "agent"); }
      asm volatile("s_waitcnt vmcnt(0) lgkmcnt(0)" ::: "memory"); __syncthreads(); }
    if (PH(1)) phase_normmod(p.x, p.ctx, p.g_mix_norm, mod, 0, (bf16_t*)(ws + WS_H), MT, G);
    SEAM();
    if (PH(2)) { pg8::Gemm g{(const bf16_t*)(ws + WS_H), (const bf16_t*)(ws + WS_WIN), ML, INP, DM, DM, DM}; pg8::StaticOrder S; S.init(ML, INP, G, blk);
      pg8::EpiBf16 E{(bf16_t*)(ws + WS_P), INP};
      pg8::gemm_phase<pg8::EpiBf16, pg8::StaticOrder, true>(lds, g, S, E); }
    if (PH(2)) { pg8::Gemm g{(const bf16_t*)(ws + WS_H), (const bf16_t*)(ws + WS_WIN), MT, INP, 256, DM, DM}; pg8::CtxSplitOrder S{blk};
      pg8::EpiSlab E{(float*)(ws + WS_SLAB)};
      pg8::gemm_phase<pg8::EpiSlab, pg8::CtxSplitOrder, true>(lds, g, S, E); }
    SEAM();
    if (PH(3)) phase_prep(p, G);
    SEAM();
    if (PH(4)) { pg8::Gemm g{(const bf16_t*)(ws + WS_QN), (const bf16_t*)(ws + WS_WQB), ML, QW, QRANK, QRANK, QRANK}; pg8::StaticOrder S; S.init(ML, QW, G, blk);
      pg8::EpiRopeQ E{(bf16_t*)(ws + WS_Q), (const f32x2*)(ws + WS_ROPE)};
      pg8::gemm_phase<pg8::EpiRopeQ, pg8::StaticOrder, true>(lds, g, S, E); }
    if (PH(4)) { pg8::Gemm g{(const bf16_t*)(ws + WS_KVN), (const bf16_t*)(ws + WS_WKVB), MT, KVW, KVRANK, KVRANK, KVRANK}; pg8::StaticOrder S; S.init(MT, KVW, G, blk);
      pg8::EpiBf16 E{(bf16_t*)(ws + WS_KV), KVW};
      pg8::gemm_phase<pg8::EpiBf16, pg8::StaticOrder, true>(lds, g, S, E); }
    SEAM();
    if (PH(5)) { const int vcu = (G % 8 == 0) ? (blk % 8) * (G / 8) + blk / 8 : blk;
      for (int u = vcu; u < NB * NH * 8; u += G) { const int bh = u >> 3, qb = u & 7;
        att::attn_unit(bh >> 3, bh & 7, qb, (const bf16_t*)(ws + WS_Q), (const bf16_t*)(ws + WS_KV), (const bf16_t*)(ws + WS_KR), p.g_mix_out, (bf16_t*)(ws + WS_MIXN), (LAS char*)lds); } }
    SEAM();
    if (PH(6)) { pg8::Gemm g{(const bf16_t*)(ws + WS_MIXN), (const bf16_t*)(ws + WS_WOUT), ML, DM, DM, DM, DM}; pg8::StaticOrder S; S.init(ML, DM, G, blk);
      pg8::RowStats st{(float*)(ws + WS_XBUF), (unsigned*)(ws + WS_CNT)};
      pg8::EpiResGateNormMod E{p.x, p.out, mod + 2 * DM, p.g_ffn_norm, mod + 3 * DM, mod + 4 * DM, (bf16_t*)(ws + WS_H), st};
      pg8::gemm_phase<pg8::EpiResGateNormMod, pg8::StaticOrder, false>(lds, g, S, E); }
    SEAM();
    if (PH(8)) { pg8::Gemm g{(const bf16_t*)(ws + WS_H), (const bf16_t*)(ws + WS_WUP), ML, FFN2, DM, DM, DM}; pg8::StaticOrder S; S.init(ML, FFN2, G, blk);
      pg8::EpiAct E{(bf16_t*)(ws + WS_ACT), (bf16_t*)(ws + WS_RAW), p.ffn_conv_w, p.ffn_conv_b};
      pg8::gemm_phase<pg8::EpiAct, pg8::StaticOrder, true>(lds, g, S, E);
      const int nun = (ML / 256) * (FFN2 / 256), rem = nun % G;
      if (rem != 0 && blk >= rem) { const int tidx = otid(), wv = tidx >> 6, ln = tidx & 63; LAS float* scr = (LAS float*)(lds + wv * 16640);
        for (int it = (blk - rem) * NWAVES + wv; it < I_DOWN; it += (G - rem) * NWAVES) p0_transpose_item(p.w_down, FFN, DM, (bf16_t*)(ws + WS_WDOWN), scr, it, ln); }
      else if (rem == 0) { const int tidx = otid(), wv = tidx >> 6, ln = tidx & 63; LAS float* scr = (LAS float*)(lds + wv * 16640);
        for (int it = blk * NWAVES + wv; it < I_DOWN; it += G * NWAVES) p0_transpose_item(p.w_down, FFN, DM, (bf16_t*)(ws + WS_WDOWN), scr, it, ln); } }
    SEAM();
    if (PH(10)) { pg8::Gemm g{(const bf16_t*)(ws + WS_ACT), (const bf16_t*)(ws + WS_WDOWN), ML, DM, FFN, FFN, FFN}; pg8::StaticOrder S; S.init(ML, DM, G, blk);
      { pg8::Unit u0; if (S.next(0, u0)) act_fixup_panel(p, u0.pm); }
      __syncthreads();
      pg8::RowStats st{(float*)(ws + WS_XBUF) + 32 * 256 * 8, (unsigned*)(ws + WS_CNT) + 32 * 64};
      pg8::EpiResGateNormFinal E{p.out, p.out, mod + 5 * DM, p.g_final, st};
      pg8::gemm_phase<pg8::EpiResGateNormFinal, pg8::StaticOrder, false>(lds, g, S, E); }
}

extern "C" void kernel_launch(void* const* d_in, const int* in_sizes, int n_in, void* d_out, int out_size, void* d_ws, size_t ws_size, hipStream_t stream) {
    static int grid = 0;
    if (grid == 0) {
        if (n_in != 22 || ws_size < WS_END) { fprintf(stderr, "kernel_launch: unexpected n_in %d / ws_size %zu (need %zu)\n", n_in, ws_size, (size_t)WS_END); grid = -1; return; }
        int dev = 0, cus = 0, per_cu = 0;
        hipGetDevice(&dev); hipDeviceGetAttribute(&cus, hipDeviceAttributeMultiprocessorCount, dev);
        if (hipFuncSetAttribute((const void*)fwd_megakernel, hipFuncAttributeMaxDynamicSharedMemorySize, LDS_BYTES) != hipSuccess) { fprintf(stderr, "kernel_launch: hipFuncSetAttribute failed\n"); grid = -1; return; }
        if (hipOccupancyMaxActiveBlocksPerMultiprocessor(&per_cu, (const void*)fwd_megakernel, NTHR, LDS_BYTES) != hipSuccess || per_cu < 1) { fprintf(stderr, "kernel_launch: occupancy query says %d\n", per_cu); per_cu = 1; }
        (void)hipGetLastError();
        grid = cus;
        if (grid != 256) { fprintf(stderr, "kernel_launch: built for a 256-CU device (got %d)\n", cus); grid = -1; return; }
    }
    if (grid < 0) return;
    hipMemsetAsync(d_ws, 0, WS_ZERO_BYTES, stream);
    Params p{};
    const float** pp = (const float**)&p;
    for (int i = 0; i < 22; ++i) pp[i] = (const float*)d_in[i];
    p.out = (float*)d_out; p.ws = (unsigned char*)d_ws;
    void* args[] = {&p};
    hipError_t e = hipLaunchCooperativeKernel((const void*)fwd_megakernel, dim3(grid), dim3(NTHR), args, LDS_BYTES, stream);
    if (e != hipSuccess) fprintf(stderr, "cooperative launch failed: %s (grid %d)\n", hipGetErrorString(e), grid);
}
```

```cpp
#include <hip/hip_runtime.h>
#include <hip/hip_cooperative_groups.h>
#include <cstdio>
#include <cstdint>
namespace cg = cooperative_groups;

#define LAS __attribute__((address_space(3)))
typedef unsigned short bf16_t;
typedef short bf16x8 __attribute__((ext_vector_type(8)));
typedef short s16x4 __attribute__((ext_vector_type(4)));
typedef float f32x2 __attribute__((ext_vector_type(2)));
typedef float f32x4 __attribute__((ext_vector_type(4)));
typedef float f32x16 __attribute__((ext_vector_type(16)));
typedef unsigned u32x2 __attribute__((ext_vector_type(2)));
typedef unsigned u32x4 __attribute__((ext_vector_type(4)));

constexpr int DM = 2048, NB = 4, SEQ = 2048, CTXL = 256;
constexpr int ML = NB * SEQ;
constexpr int MC = NB * CTXL;
constexpr int MT = ML + MC;
constexpr int QRANK = 512, KVRANK = 256, ROPE = 64, CONVW = 1024, NH = 8, DQK = 192, DV = 128;
constexpr int INC = 3904, INP = 4096;
constexpr int FFN = 5504, FFN2 = 11008;
constexpr int QW = NH * DQK;
constexpr int KVW = NH * 256;
constexpr int C_QA = 0, C_KVA = 512, C_KR = 768, C_CB = 832, C_CC = 1856, C_CH = 2880;
constexpr float EPS = 1e-6f;
constexpr int NWAVES = 8, NTHR = 512;
constexpr int LDS_BYTES = 163840;

constexpr size_t MiB = 1u << 20;
constexpr size_t WS_MOD = 0;
constexpr size_t MOD_BYTES = 5 * 12288 * 4;
constexpr size_t WS_BAR = 256 * 1024;
constexpr size_t WS_CNT = 320 * 1024;
constexpr size_t WS_ZERO_BYTES = 512 * 1024;
constexpr size_t WS_ROPE = 512 * 1024;
constexpr size_t WS_WDOWN = 1 * MiB + 0;
constexpr size_t WS_WIN = 23 * MiB;
constexpr size_t WS_WQB = 39 * MiB;
constexpr size_t WS_WKVB = 41 * MiB;
constexpr size_t WS_WOUT = 42 * MiB;
constexpr size_t WS_WUP = 50 * MiB;
constexpr size_t WS_H = 93 * MiB;
constexpr size_t WS_RAW = 129 * MiB;
constexpr size_t WS_ACT = 141 * MiB;
constexpr size_t WS_P = 129 * MiB;
constexpr size_t WS_QN = 201 * MiB;
constexpr size_t WS_KVN = 209 * MiB;
constexpr size_t WS_KR = 214 * MiB;
constexpr size_t WS_Q = 216 * MiB;
constexpr size_t WS_KV = 240 * MiB;
constexpr size_t WS_MIXN = 276 * MiB;
constexpr size_t WS_U = 129 * MiB;
constexpr size_t WS_SLAB = 308 * MiB;
constexpr size_t WS_XBUF = 324 * MiB;
constexpr size_t WS_END = 325 * MiB;

__device__ __forceinline__ int otid() { int t = threadIdx.x; asm volatile("" : "+v"(t)); return t; }
__device__ __forceinline__ unsigned cvt_pk_bf16(float lo, float hi) { unsigned r; asm volatile("v_cvt_pk_bf16_f32 %0, %1, %2" : "=v"(r) : "v"(lo), "v"(hi)); return r; }
__device__ __forceinline__ float bf_lo(unsigned w) { return __uint_as_float(w << 16); }
__device__ __forceinline__ float bf_hi(unsigned w) { return __uint_as_float(w & 0xffff0000u); }
__device__ __forceinline__ void unpack8(const u32x4 w, float* f) { f[0] = bf_lo(w.x); f[1] = bf_hi(w.x); f[2] = bf_lo(w.y); f[3] = bf_hi(w.y); f[4] = bf_lo(w.z); f[5] = bf_hi(w.z); f[6] = bf_lo(w.w); f[7] = bf_hi(w.w); }
__device__ __forceinline__ u32x4 pack8(const float* f) { u32x4 w; w.x = cvt_pk_bf16(f[0], f[1]); w.y = cvt_pk_bf16(f[2], f[3]); w.z = cvt_pk_bf16(f[4], f[5]); w.w = cvt_pk_bf16(f[6], f[7]); return w; }
__device__ __forceinline__ float wave_sum(float v) {
#pragma unroll
    for (int o = 1; o < 64; o <<= 1) v += __shfl_xor(v, o);
    return v;
}
__device__ __forceinline__ void st16_wt(void* p, u32x4 v) { asm volatile("global_store_dwordx4 %0, %1, off sc1\n\ts_nop 1" :: "v"(p), "v"(v) : "memory"); }
__device__ __forceinline__ float silu_f(float x) { return x * __builtin_amdgcn_rcpf(1.0f + __builtin_amdgcn_exp2f(-1.4426950408889634f * x)); }

namespace pg8 {
constexpr int BM = 256, BK = 64, HALF = 128, HTB = HALF * BK * 2, STAGE_BYTES = 8 * HTB, NXCD = 8, WGM = 4;
__host__ __device__ __forceinline__ int lds_byte(int r, int c) { const int st = (r >> 4) * 2 + (c >> 5), rr = r & 15, cc = c & 31, ob = rr * 64 + cc * 2; return st * 1024 + (ob ^ (((ob >> 9) & 1) << 5)); }
__host__ __device__ __forceinline__ void stage_rc(int b, int& R, int& C) { const int st = b / 1024, sb = b % 1024, swz = sb ^ (((sb >> 9) & 1) << 5); R = (st >> 1) * 16 + swz / 64; C = (st & 1) * 32 + (swz % 64) / 2; }
__host__ __device__ __forceinline__ int perm32(int rho) { const int n = rho >> 4, i = rho & 15; return 8 * (i >> 2) + 4 * n + (i & 3); }
struct Unit { int pm, pn, ko; };
struct Gemm { const bf16_t* A; const bf16_t* Bt; int M, N, K, lda, ldb; };
struct StaticOrder {
    int nM, nN, nwg, G, c;
    __device__ void init(int M, int N, int G_, int c_) { nM = M / BM; nN = N / BM; nwg = nM * nN; G = G_; c = c_; }
    __device__ bool next(int i, Unit& u) const {
        const long L = (long)i * G + c; if (L >= nwg) return false;
        int wgid = (int)L; { const int q = nwg / NXCD, r = nwg % NXCD, xcd = wgid % NXCD, off = wgid / NXCD; wgid = (xcd < r ? xcd * (q + 1) : r * (q + 1) + (xcd - r) * q) + off; }
        const int nig = WGM * nN, gid = wgid / nig, fm = gid * WGM, gsz = (nM - fm) < WGM ? (nM - fm) : WGM;
        u.pm = fm + ((wgid % nig) % gsz); u.pn = (wgid % nig) / gsz; u.ko = 0; return true;
    }
};
struct EpiBf16 {
    static constexpr bool PERM = true, AFTER_DRAIN = false;
    bf16_t* O; int ldc;
    __device__ __forceinline__ void operator()(const f32x4 (&acc)[2][2][4][2], const Unit& u, int wr, int wc, int fr, int fq) const {
        const int row0 = u.pm * BM + wr * 64 + fr, col0 = u.pn * BM + wc * 32 + 8 * fq;
#pragma unroll
        for (int ai = 0; ai < 2; ++ai)
#pragma unroll
            for (int m = 0; m < 4; ++m) { bf16_t* rowp = O + (size_t)(row0 + ai * HALF + m * 16) * ldc + col0;
#pragma unroll
                for (int bj = 0; bj < 2; ++bj) { const f32x4 v0 = acc[ai][bj][m][0], v1 = acc[ai][bj][m][1];
                    u32x4 w; w.x = cvt_pk_bf16(v0[0], v0[1]); w.y = cvt_pk_bf16(v0[2], v0[3]); w.z = cvt_pk_bf16(v1[0], v1[1]); w.w = cvt_pk_bf16(v1[2], v1[3]);
                    st16_wt(rowp + bj * HALF, w); } }
    }
};
struct EpiRopeQ {
    static constexpr bool PERM = true, AFTER_DRAIN = false;
    bf16_t* O; const f32x2* tab;
    __device__ __forceinline__ void operator()(const f32x4 (&acc)[2][2][4][2], const Unit& u, int wr, int wc, int fr, int fq) const {
        const int row0 = u.pm * BM + wr * 64 + fr, col0 = u.pn * BM + wc * 32 + 8 * fq;
#pragma unroll
        for (int bj = 0; bj < 2; ++bj) {
            const int col = col0 + bj * HALF; const int d = col % DQK; const bool rot = d >= 128; const int i0 = (d - 128) >> 1;
#pragma unroll
            for (int ai = 0; ai < 2; ++ai)
#pragma unroll
                for (int m = 0; m < 4; ++m) { const int row = row0 + ai * HALF + m * 16;
                    f32x4 v0 = acc[ai][bj][m][0], v1 = acc[ai][bj][m][1];
                    if (rot) { const f32x4* tp = (const f32x4*)(tab + (size_t)(row & (SEQ - 1)) * 32 + i0); const f32x4 c0 = tp[0], c1 = tp[1];
                        const f32x4 a = v0, b = v1;
                        v0[0] = a[0] * c0[0] - a[1] * c0[1]; v0[1] = a[0] * c0[1] + a[1] * c0[0]; v0[2] = a[2] * c0[2] - a[3] * c0[3]; v0[3] = a[2] * c0[3] + a[3] * c0[2];
                        v1[0] = b[0] * c1[0] - b[1] * c1[1]; v1[1] = b[0] * c1[1] + b[1] * c1[0]; v1[2] = b[2] * c1[2] - b[3] * c1[3]; v1[3] = b[2] * c1[3] + b[3] * c1[2]; }
                    u32x4 w; w.x = cvt_pk_bf16(v0[0], v0[1]); w.y = cvt_pk_bf16(v0[2], v0[3]); w.z = cvt_pk_bf16(v1[0], v1[1]); w.w = cvt_pk_bf16(v1[2], v1[3]);
                    st16_wt(O + (size_t)row * QW + col, w); }
        }
    }
};
struct CtxSplitOrder {
    int c;
    __device__ bool next(int i, Unit& u) const { if (i != 0 || c >= 64) return false; u.pm = 32 + (c >> 4); u.pn = 2 + ((c >> 3) & 1); u.ko = (c & 7) * 256; return true; }
};
struct EpiSlab {
    static constexpr bool PERM = false, AFTER_DRAIN = false;
    float* S;
    __device__ __forceinline__ void operator()(const f32x4 (&acc)[2][2][4][2], const Unit& u, int wr, int wc, int fr, int fq) const {
        float* sp = S + (size_t)(u.ko >> 8) * (1024 * 512) + (size_t)((u.pm - 32) * BM + wr * 64 + fr) * 512 + (u.pn - 2) * BM + wc * 32 + 4 * fq;
#pragma unroll
        for (int ai = 0; ai < 2; ++ai)
#pragma unroll
            for (int m = 0; m < 4; ++m)
#pragma unroll
                for (int bj = 0; bj < 2; ++bj)
#pragma unroll
                    for (int n = 0; n < 2; ++n) *(f32x4*)(sp + (size_t)(ai * HALF + m * 16) * 512 + bj * HALF + n * 16) = acc[ai][bj][m][n];
    }
};
struct EpiResGate {
    static constexpr bool PERM = false, AFTER_DRAIN = false;
    const float* base; float* out; const float* gate;
    __device__ __forceinline__ void operator()(const f32x4 (&acc)[2][2][4][2], const Unit& u, int wr, int wc, int fr, int fq) const {
        const int col0 = u.pn * BM + wc * 32 + 4 * fq; const float* gp = gate + (size_t)(u.pm >> 3) * 12288 + col0;
        f32x4 gv[2][2];
#pragma unroll
        for (int bj = 0; bj < 2; ++bj)
#pragma unroll
            for (int n = 0; n < 2; ++n) gv[bj][n] = *(const f32x4*)(gp + bj * HALF + n * 16);
#pragma unroll
        for (int ai = 0; ai < 2; ++ai)
#pragma unroll
            for (int m = 0; m < 4; ++m) { const size_t off = (size_t)(u.pm * BM + ai * HALF + wr * 64 + m * 16 + fr) * DM + col0;
#pragma unroll
                for (int bj = 0; bj < 2; ++bj)
#pragma unroll
                    for (int n = 0; n < 2; ++n) { const f32x4 bs = *(const f32x4*)(base + off + bj * HALF + n * 16);
                        *(f32x4*)(out + off + bj * HALF + n * 16) = bs + gv[bj][n] * acc[ai][bj][m][n]; }
                if (m & 1) asm volatile("" ::: "memory"); }
    }
};

template <int SEL> __device__ __forceinline__ void fmac_dpp(float& d, float x, float w) {
    if (SEL == 0)      asm("v_fmac_f32_dpp %0, %1, %2 row_shr:1 row_mask:0xf bank_mask:0xf bound_ctrl:1" : "+v"(d) : "v"(x), "v"(w));
    else if (SEL == 1) asm("v_fmac_f32_dpp %0, %1, %2 row_shl:1 row_mask:0xf bank_mask:0xf bound_ctrl:1" : "+v"(d) : "v"(x), "v"(w));
    else if (SEL == 2) asm("v_fmac_f32_dpp %0, %1, %2 row_ror:1 row_mask:0xf bank_mask:0xf" : "+v"(d) : "v"(x), "v"(w));
    else               asm("v_fmac_f32_dpp %0, %1, %2 row_ror:15 row_mask:0xf bank_mask:0xf" : "+v"(d) : "v"(x), "v"(w));
}
struct EpiAct {
    static constexpr bool PERM = true, AFTER_DRAIN = false;
    bf16_t* ACT; bf16_t* RAW; const float* cw; const float* cb;
    __device__ __forceinline__ void operator()(const f32x4 (&acc)[2][2][4][2], const Unit& u, int wr, int wc, int fr, int fq) const {
        const int jc = u.pn * 128 + wc * 32 + 8 * fq;
        const int tc = u.pn * BM + wc * 32 + 8 * fq;
        const float m0 = (fr == 0) ? 1.f : 0.f, m15 = (fr == 15) ? 1.f : 0.f;
        u32x2 stash[2][4];
#pragma unroll
        for (int n = 0; n < 2; ++n) {
            const int j = jc + 4 * n;
            const f32x4 a0 = *(const f32x4*)(cw + j), a1 = *(const f32x4*)(cw + FFN2 + j), a2 = *(const f32x4*)(cw + 2 * FFN2 + j), ab = *(const f32x4*)(cb + j);
            const f32x4 g0 = *(const f32x4*)(cw + FFN + j), g1 = *(const f32x4*)(cw + FFN2 + FFN + j), g2 = *(const f32x4*)(cw + 2 * FFN2 + FFN + j), gb = *(const f32x4*)(cb + FFN + j);
            const f32x4 a0z = a0 * m0, a2z = a2 * m15, g0z = g0 * m0, g2z = g2 * m15;
#pragma unroll
            for (int ai = 0; ai < 2; ++ai) {
                const int rowb = u.pm * BM + ai * HALF + wr * 64;
#pragma unroll
                for (int m = 0; m < 4; ++m) {
                    f32x4 ya, yg;
#pragma unroll
                    for (int e = 0; e < 4; ++e) {
                        const float xa = acc[ai][0][m][n][e], xg = acc[ai][1][m][n][e];
                        float ca = ab[e] + a1[e] * xa, cg = gb[e] + g1[e] * xg;
                        fmac_dpp<0>(ca, xa, a0[e]); fmac_dpp<0>(cg, xg, g0[e]);
                        fmac_dpp<1>(ca, xa, a2[e]); fmac_dpp<1>(cg, xg, g2[e]);
                        if (m > 0) { fmac_dpp<2>(ca, acc[ai][0][m - 1][n][e], a0z[e]); fmac_dpp<2>(cg, acc[ai][1][m - 1][n][e], g0z[e]); }
                        if (m < 3) { fmac_dpp<3>(ca, acc[ai][0][m + 1][n][e], a2z[e]); fmac_dpp<3>(cg, acc[ai][1][m + 1][n][e], g2z[e]); }
                        ya[e] = ca; yg[e] = cg;
                    }
                    u32x2 w;
                    w.x = cvt_pk_bf16(ya[0] * silu_f(yg[0]), ya[1] * silu_f(yg[1])); w.y = cvt_pk_bf16(ya[2] * silu_f(yg[2]), ya[3] * silu_f(yg[3]));
                    if (n == 0) stash[ai][m] = w;
                    else { u32x4 w4; w4.x = stash[ai][m].x; w4.y = stash[ai][m].y; w4.z = w.x; w4.w = w.y; st16_wt(ACT + (size_t)(rowb + m * 16 + fr) * FFN + jc, w4); }
                    if ((m == 0 && fr < 2) || (m == 3 && fr >= 14)) {
                        const int idx = (m == 0) ? fr : fr - 12;
                        bf16_t* rp = RAW + (size_t)((rowb >> 6) * 4 + idx) * FFN2 + tc + 4 * n;
                        const f32x4 ra = acc[ai][0][m][n], rg = acc[ai][1][m][n];
                        u32x2 wa, wg; wa.x = cvt_pk_bf16(ra[0], ra[1]); wa.y = cvt_pk_bf16(ra[2], ra[3]); wg.x = cvt_pk_bf16(rg[0], rg[1]); wg.y = cvt_pk_bf16(rg[2], rg[3]);
                        *(u32x2*)rp = wa; *(u32x2*)(rp + HALF) = wg; }
                }
            }
        }
    }
};

struct RowStats {
    float* xbuf;
    unsigned* cnt;
    __device__ __forceinline__ void run(const f32x4 (&v)[2][2][4][2], const Unit& u, int wr, int wc, int fr, int fq, LAS unsigned char* lds, int wid, int lane) const {
        LAS float* P = (LAS float*)lds;
        LAS float* S = (LAS float*)(lds + 8192);
#pragma unroll
        for (int ai = 0; ai < 2; ++ai)
#pragma unroll
            for (int m = 0; m < 4; ++m) { float q = 0.f;
#pragma unroll
                for (int bj = 0; bj < 2; ++bj)
#pragma unroll
                    for (int n = 0; n < 2; ++n) { const f32x4 x = v[ai][bj][m][n]; q += (x[0] * x[0] + x[1] * x[1]) + (x[2] * x[2] + x[3] * x[3]); }
                q += __shfl_xor(q, 16); q += __shfl_xor(q, 32);
                if (fq == 0) P[(ai * HALF + wr * 64 + m * 16 + fr) * 4 + wc] = q; }
        asm volatile("s_waitcnt lgkmcnt(0)" ::: "memory"); __builtin_amdgcn_s_barrier(); asm volatile("" ::: "memory");
        const int row = wid * 32 + (lane & 31);
        if (lane < 32) { const float t = (P[row * 4 + 0] + P[row * 4 + 1]) + (P[row * 4 + 2] + P[row * 4 + 3]);
            __hip_atomic_store(xbuf + ((size_t)(u.pm * BM + row) * 8 + u.pn), t, __ATOMIC_RELAXED, __HIP_MEMORY_SCOPE_AGENT); }
        asm volatile("s_waitcnt vmcnt(0)" ::: "memory");
        if (lane == 0) __hip_atomic_fetch_add(cnt + 64 * u.pm, 1u, __ATOMIC_RELAXED, __HIP_MEMORY_SCOPE_AGENT);
        if (wid == 0) { unsigned sp = 0;
            while ((unsigned)__builtin_amdgcn_readfirstlane(__hip_atomic_load(cnt + 64 * u.pm, __ATOMIC_RELAXED, __HIP_MEMORY_SCOPE_AGENT)) < 64u) { __builtin_amdgcn_s_sleep(2); if (++sp > (1u << 20)) break; }
            __builtin_amdgcn_fence(__ATOMIC_ACQUIRE, "agent"); }
        asm volatile("s_waitcnt vmcnt(0) lgkmcnt(0)" ::: "memory"); __builtin_amdgcn_s_barrier(); asm volatile("" ::: "memory");
        if (lane < 32) { const float* slot = xbuf + (size_t)(u.pm * BM + row) * 8; float t = 0.f;
#pragma unroll
            for (int k = 0; k < 8; ++k) t += __hip_atomic_load(slot + k, __ATOMIC_RELAXED, __HIP_MEMORY_SCOPE_AGENT);
            S[row] = rsqrtf(t * (1.0f / DM) + EPS); }
        asm volatile("s_waitcnt lgkmcnt(0)" ::: "memory"); __builtin_amdgcn_s_barrier(); asm volatile("" ::: "memory");
    }
};
struct EpiResGateNormMod {
    static constexpr bool PERM = false, AFTER_DRAIN = true;
    const float* base; float* out; const float* gate; const float* g; const float* sh; const float* sc; bf16_t* HF; RowStats st;
    __device__ __forceinline__ void fused(f32x4 (&acc)[2][2][4][2], const Unit& u, int wr, int wc, int fr, int fq, LAS unsigned char* lds, int wid, int lane) const {
        const LAS float* S = (const LAS float*)(lds + 8192);
        const int col0 = u.pn * BM + wc * 32 + 4 * fq; const size_t mo = (size_t)(u.pm >> 3) * 12288 + col0;
        { f32x4 gv[2][2];
#pragma unroll
          for (int bj = 0; bj < 2; ++bj)
#pragma unroll
            for (int n = 0; n < 2; ++n) gv[bj][n] = *(const f32x4*)(gate + mo + bj * HALF + n * 16);
#pragma unroll
          for (int ai = 0; ai < 2; ++ai)
#pragma unroll
            for (int m = 0; m < 4; ++m) { const size_t off = (size_t)(u.pm * BM + ai * HALF + wr * 64 + m * 16 + fr) * DM + col0;
#pragma unroll
                for (int bj = 0; bj < 2; ++bj)
#pragma unroll
                    for (int n = 0; n < 2; ++n) { const f32x4 bs = __builtin_nontemporal_load((const f32x4*)(base + off + bj * HALF + n * 16)); acc[ai][bj][m][n] = bs + gv[bj][n] * acc[ai][bj][m][n]; }
                asm volatile("" : "+v"(acc[ai][0][m][0]), "+v"(acc[ai][0][m][1]), "+v"(acc[ai][1][m][0]), "+v"(acc[ai][1][m][1]));
                if (m == 3) asm volatile("" ::: "memory"); } }
        st.run(acc, u, wr, wc, fr, fq, lds, wid, lane);
        f32x4 A[2][2], Bv[2][2];
#pragma unroll
        for (int bj = 0; bj < 2; ++bj)
#pragma unroll
            for (int n = 0; n < 2; ++n) { const f32x4 gg = *(const f32x4*)(g + col0 + bj * HALF + n * 16), s4 = *(const f32x4*)(sc + mo + bj * HALF + n * 16);
                A[bj][n] = gg * (s4 + 1.0f); Bv[bj][n] = *(const f32x4*)(sh + mo + bj * HALF + n * 16); }
#pragma unroll
        for (int ai = 0; ai < 2; ++ai)
#pragma unroll
            for (int m = 0; m < 4; ++m) { const int r = ai * HALF + wr * 64 + m * 16 + fr; const float rs = S[r]; const size_t off = (size_t)(u.pm * BM + r) * DM + col0;
#pragma unroll
                for (int bj = 0; bj < 2; ++bj)
#pragma unroll
                    for (int n = 0; n < 2; ++n) { const f32x4 x1 = acc[ai][bj][m][n]; __builtin_nontemporal_store(x1, (f32x4*)(out + off + bj * HALF + n * 16));
                        const f32x4 y = x1 * rs * A[bj][n] + Bv[bj][n]; u32x2 w; w.x = cvt_pk_bf16(y[0], y[1]); w.y = cvt_pk_bf16(y[2], y[3]);
                        *(u32x2*)(HF + off + bj * HALF + n * 16) = w; }
                asm volatile("" ::: "memory"); }
    }
};
struct EpiResGateNormFinal {
    static constexpr bool PERM = false, AFTER_DRAIN = true;
    const float* base; float* out; const float* gate; const float* g; RowStats st;
    __device__ __forceinline__ void fused(f32x4 (&acc)[2][2][4][2], const Unit& u, int wr, int wc, int fr, int fq, LAS unsigned char* lds, int wid, int lane) const {
        const LAS float* S = (const LAS float*)(lds + 8192);
        const int col0 = u.pn * BM + wc * 32 + 4 * fq; const size_t mo = (size_t)(u.pm >> 3) * 12288 + col0;
        { f32x4 gv[2][2];
#pragma unroll
          for (int bj = 0; bj < 2; ++bj)
#pragma unroll
            for (int n = 0; n < 2; ++n) gv[bj][n] = *(const f32x4*)(gate + mo + bj * HALF + n * 16);
#pragma unroll
          for (int ai = 0; ai < 2; ++ai)
#pragma unroll
            for (int m = 0; m < 4; ++m) { const size_t off = (size_t)(u.pm * BM + ai * HALF + wr * 64 + m * 16 + fr) * DM + col0;
#pragma unroll
                for (int bj = 0; bj < 2; ++bj)
#pragma unroll
                    for (int n = 0; n < 2; ++n) { const f32x4 bs = __builtin_nontemporal_load((const f32x4*)(base + off + bj * HALF + n * 16)); acc[ai][bj][m][n] = bs + gv[bj][n] * acc[ai][bj][m][n]; }
                asm volatile("" : "+v"(acc[ai][0][m][0]), "+v"(acc[ai][0][m][1]), "+v"(acc[ai][1][m][0]), "+v"(acc[ai][1][m][1]));
                if (m == 3) asm volatile("" ::: "memory"); } }
        st.run(acc, u, wr, wc, fr, fq, lds, wid, lane);
        f32x4 A[2][2];
#pragma unroll
        for (int bj = 0; bj < 2; ++bj)
#pragma unroll
            for (int n = 0; n < 2; ++n) A[bj][n] = *(const f32x4*)(g + col0 + bj * HALF + n * 16);
#pragma unroll
        for (int ai = 0; ai < 2; ++ai)
#pragma unroll
            for (int m = 0; m < 4; ++m) { const int r = ai * HALF + wr * 64 + m * 16 + fr; const float rs = S[r]; const size_t off = (size_t)(u.pm * BM + r) * DM + col0;
#pragma unroll
                for (int bj = 0; bj < 2; ++bj)
#pragma unroll
                    for (int n = 0; n < 2; ++n) __builtin_nontemporal_store(acc[ai][bj][m][n] * rs * A[bj][n], (f32x4*)(out + off + bj * HALF + n * 16));
                asm volatile("" ::: "memory"); }
    }
};

template <class Epi, class Sched, bool ALIGN_EPI>
__device__ __forceinline__ void gemm_phase(LAS unsigned char* lds, const Gemm g, const Sched& S, const Epi& E) {
    const int tid = otid(), wid = __builtin_amdgcn_readfirstlane(tid >> 6), lane = tid & 63, wr = wid >> 2, wc = wid & 3, fr = lane & 15, fq = lane >> 4;
    const int K = g.K, nt = K / BK;
    unsigned voffA[2], voffB[2];
#pragma unroll
    for (int i = 0; i < 2; ++i) { int R, C; stage_rc(tid * 16 + i * 8192, R, C); const int Rb = Epi::PERM ? ((R & ~31) + perm32(R & 31)) : R;
        voffA[i] = (unsigned)(R * g.lda + C) * 2u; voffB[i] = (unsigned)(Rb * g.ldb + C) * 2u; }
    const size_t kstep = (size_t)(BK * 2);
    const size_t hstepA = (size_t)HALF * g.lda * 2, hstepB = (size_t)HALF * g.ldb * 2;
    const size_t tstepA = 2 * hstepA, tstepB = 2 * hstepB;
    const unsigned ldsw = (unsigned)wid * 1024u;
    const int aoff = lds_byte(wr * 64 + fr, fq * 8), boff = lds_byte(wc * 32 + fr, fq * 8);
#define PG8_SA(b, h) (((b) * 2 + (h)) * HTB)
#define PG8_SB(b, h) ((4 + (b) * 2 + (h)) * HTB)
#define PG8_STAGE(bufoff, gbase, voff) do { _Pragma("unroll") for (int _i = 0; _i < 2; ++_i) \
        __builtin_amdgcn_global_load_lds((const unsigned*)((const char*)(gbase) + (voff)[_i]), (LAS unsigned*)(lds + (bufoff) + ldsw + _i * 8192), 16, 0, 0); } while (0)
#define PG8_LDA(dst, b, h) do { _Pragma("unroll") for (int m = 0; m < 4; ++m) _Pragma("unroll") for (int k = 0; k < 2; ++k) dst[m][k] = *(const LAS bf16x8*)(lds + PG8_SA(b, h) + aoff + m * 2048 + k * 1024); } while (0)
#define PG8_LDB(dst, b, h) do { _Pragma("unroll") for (int n = 0; n < 2; ++n) _Pragma("unroll") for (int k = 0; k < 2; ++k) dst[n][k] = *(const LAS bf16x8*)(lds + PG8_SB(b, h) + boff + n * 2048 + k * 1024); } while (0)
#define PG8_MMA(ai, bj, At, Bt) do { __builtin_amdgcn_s_setprio(1); _Pragma("unroll") for (int m = 0; m < 4; ++m) _Pragma("unroll") for (int n = 0; n < 2; ++n) _Pragma("unroll") for (int k = 0; k < 2; ++k) \
        acc[ai][bj][m][n] = __builtin_amdgcn_mfma_f32_16x16x32_bf16(Bt[n][k], At[m][k], acc[ai][bj][m][n], 0, 0, 0); __builtin_amdgcn_s_setprio(0); } while (0)
#define PG8_WAIT_V(n) asm volatile("s_waitcnt vmcnt(" #n ")" ::: "memory")
#define PG8_WAIT_L(n) asm volatile("s_waitcnt lgkmcnt(" #n ")" ::: "memory")
#define PG8_BAR __builtin_amdgcn_s_barrier()
#define PG8_SCHED __builtin_amdgcn_sched_barrier(0)
    Unit cur, nxt; int ui = 0;
    if (!S.next(0, cur)) return;
    f32x4 acc[2][2][4][2];
#pragma unroll
    for (int a = 0; a < 2; ++a)
#pragma unroll
        for (int b = 0; b < 2; ++b)
#pragma unroll
            for (int m = 0; m < 4; ++m)
#pragma unroll
                for (int n = 0; n < 2; ++n) acc[a][b][m][n] = (f32x4){0.f, 0.f, 0.f, 0.f};
    bf16x8 At[4][2], B0[2][2], B1[2][2];
    const char* cA = (const char*)g.A + (size_t)cur.pm * tstepA + (size_t)cur.ko * 2; const char* cB = (const char*)g.Bt + (size_t)cur.pn * tstepB + (size_t)cur.ko * 2;
    PG8_STAGE(PG8_SB(0, 0), cB, voffB); PG8_STAGE(PG8_SB(0, 1), cB + hstepB, voffB); PG8_STAGE(PG8_SA(0, 0), cA, voffA); PG8_STAGE(PG8_SA(0, 1), cA + hstepA, voffA);
    if (wr == 1) PG8_BAR;
    PG8_WAIT_V(2); PG8_BAR;
    PG8_STAGE(PG8_SB(1, 0), cB + kstep, voffB); PG8_STAGE(PG8_SA(1, 0), cA + kstep, voffA); PG8_STAGE(PG8_SB(1, 1), cB + hstepB + kstep, voffB);
    PG8_WAIT_V(6); PG8_BAR;
    for (;;) {
        const bool has_next = S.next(ui + 1, nxt);
        const char* nA = has_next ? (const char*)g.A + (size_t)nxt.pm * tstepA + (size_t)nxt.ko * 2 : cA; const char* nB = has_next ? (const char*)g.Bt + (size_t)nxt.pn * tstepB + (size_t)nxt.ko * 2 : cB;
        for (int t = 0; t < nt; t += 2) {
            const bool last = (t == nt - 2);
            const char* a1 = cA + (size_t)(t + 1) * kstep;
            const char* a2 = last ? nA : cA + (size_t)(t + 2) * kstep; const char* b2 = last ? nB : cB + (size_t)(t + 2) * kstep;
            const char* a3 = a2 + kstep; const char* b3 = b2 + kstep;
            PG8_LDB(B0, 0, 0); PG8_LDB(B1, 0, 1); PG8_SCHED; PG8_LDA(At, 0, 0); PG8_STAGE(PG8_SA(1, 1), a1 + hstepA, voffA);
            PG8_WAIT_V(8); PG8_WAIT_L(0); PG8_BAR; PG8_MMA(0, 0, At, B0); PG8_MMA(0, 1, At, B1); PG8_BAR; PG8_SCHED;
            PG8_LDA(At, 0, 1); PG8_STAGE(PG8_SB(0, 0), b2, voffB); PG8_STAGE(PG8_SB(0, 1), b2 + hstepB, voffB); PG8_STAGE(PG8_SA(0, 0), a2, voffA);
            PG8_WAIT_V(8); PG8_WAIT_L(0); PG8_BAR; PG8_MMA(1, 0, At, B0); PG8_MMA(1, 1, At, B1); PG8_BAR; PG8_SCHED;
            PG8_LDB(B0, 1, 0); PG8_LDB(B1, 1, 1); PG8_SCHED; PG8_LDA(At, 1, 0); PG8_STAGE(PG8_SA(0, 1), a2 + hstepA, voffA);
            PG8_WAIT_V(8); PG8_WAIT_L(0); PG8_BAR; PG8_MMA(0, 0, At, B0); PG8_MMA(0, 1, At, B1); PG8_BAR; PG8_SCHED;
            PG8_LDA(At, 1, 1); PG8_STAGE(PG8_SB(1, 0), b3, voffB); PG8_STAGE(PG8_SB(1, 1), b3 + hstepB, voffB); PG8_STAGE(PG8_SA(1, 0), a3, voffA);
            PG8_WAIT_V(8); PG8_WAIT_L(0); PG8_BAR; PG8_MMA(1, 0, At, B0); PG8_MMA(1, 1, At, B1); PG8_BAR; PG8_SCHED;
        }
        if constexpr (ALIGN_EPI) { if (wr == 0) PG8_BAR; }
        if constexpr (!Epi::AFTER_DRAIN) E(acc, cur, wr, wc, fr, fq);
        if (!has_next) break;
#pragma unroll
        for (int a = 0; a < 2; ++a)
#pragma unroll
            for (int b = 0; b < 2; ++b)
#pragma unroll
                for (int m = 0; m < 4; ++m)
#pragma unroll
                    for (int n = 0; n < 2; ++n) acc[a][b][m][n] = (f32x4){0.f, 0.f, 0.f, 0.f};
        cur = nxt; cA = nA; cB = nB; ++ui;
        if constexpr (ALIGN_EPI) { if (wr == 1) PG8_BAR; }
    }
    PG8_WAIT_V(0);
    if constexpr (!ALIGN_EPI) { if (wr == 0) PG8_BAR; }
    PG8_BAR;
    if constexpr (Epi::AFTER_DRAIN) E.fused(acc, cur, wr, wc, fr, fq, lds, wid, lane);
#undef PG8_SA
#undef PG8_SB
#undef PG8_STAGE
#undef PG8_LDA
#undef PG8_LDB
#undef PG8_MMA
#undef PG8_WAIT_V
#undef PG8_WAIT_L
#undef PG8_BAR
#undef PG8_SCHED
}
}

namespace att {
constexpr int QBLK = 32, KVBLK = 64;
constexpr float SCALE = 0.07216878364870322f;
constexpr float THR = 8.f;
constexpr int SHM_V = KVBLK * 128 * 2, SHM_K = KVBLK * 128 * 2, SHM_KR = KVBLK * 64 * 2;
constexpr int NSLOT = 3, OFF_V = 0, OFF_K = NSLOT * SHM_V, OFF_KR = OFF_K + NSLOT * SHM_K, OFF_WS = OFF_KR + NSLOT * SHM_KR, OFF_QR = OFF_WS + 2048;
#define KSWZ(row, colB) ((row) * 256 + ((colB) ^ (((row) & 7) << 4)))
#define KRSWZ(row, colB) ((row) * 128 + ((colB) ^ (((row) & 7) << 4)))
#define SBAR() __builtin_amdgcn_sched_barrier(0)
__device__ __forceinline__ int crow(int r, int hi) { return (r & 3) + 8 * (r >> 2) + 4 * hi; }
__device__ __forceinline__ void partialSM(f32x16& p0, f32x16& p1, float& m_reg, float& mn, float& alpha) {
  constexpr float C = SCALE * 1.4426950408889634f;
  float pmax = p0[0];
#pragma unroll
  for (int r = 1; r < 16; ++r) pmax = fmaxf(pmax, p0[r]);
#pragma unroll
  for (int r = 0; r < 16; ++r) pmax = fmaxf(pmax, p1[r]);
  { auto rr = __builtin_amdgcn_permlane32_swap(__float_as_uint(pmax), __float_as_uint(pmax), false, false);
    pmax = fmaxf(__uint_as_float(rr[0]), __uint_as_float(rr[1])); }
  if (__builtin_expect(__all(pmax - m_reg <= THR / SCALE), 1)) { mn = m_reg; alpha = 1.f; }
  else { mn = fmaxf(m_reg, pmax); alpha = __builtin_amdgcn_exp2f((m_reg - mn) * C); m_reg = mn; }
  float mnC = -mn * C;
#pragma unroll
  for (int r = 0; r < 16; ++r) p0[r] = fmaf(p0[r], C, mnC);
#pragma unroll
  for (int r = 0; r < 16; ++r) p1[r] = fmaf(p1[r], C, mnC);
#pragma unroll
  for (int r = 0; r < 16; ++r) p0[r] = __builtin_amdgcn_exp2f(p0[r]);
}
__device__ __forceinline__ void finishSM(f32x16& p0, f32x16& p1, float alpha, float& l_reg, bf16x8& pa0, bf16x8& pa1, bf16x8& pa2, bf16x8& pa3) {
#pragma unroll
  for (int r = 0; r < 16; ++r) p1[r] = __builtin_amdgcn_exp2f(p1[r]);
  float ps = 0;
#pragma unroll
  for (int r = 0; r < 16; ++r) ps += p0[r];
#pragma unroll
  for (int r = 0; r < 16; ++r) ps += p1[r];
  { auto rr = __builtin_amdgcn_permlane32_swap(__float_as_uint(ps), __float_as_uint(ps), false, false);
    ps = __uint_as_float(rr[0]) + __uint_as_float(rr[1]); }
  l_reg = l_reg * alpha + ps;
#define PK4(P, BASE, OUT) do { unsigned a0 = cvt_pk_bf16(P[BASE + 0], P[BASE + 1]), a1 = cvt_pk_bf16(P[BASE + 2], P[BASE + 3]);   \
    unsigned b0 = cvt_pk_bf16(P[BASE + 4], P[BASE + 5]), b1 = cvt_pk_bf16(P[BASE + 6], P[BASE + 7]);                              \
    auto r0 = __builtin_amdgcn_permlane32_swap(a0, b0, false, false); auto r1 = __builtin_amdgcn_permlane32_swap(a1, b1, false, false); \
    u32x4 w = {r0[0], r1[0], r0[1], r1[1]}; OUT = *reinterpret_cast<bf16x8*>(&w); } while (0)
  PK4(p0, 0, pa0); PK4(p0, 8, pa1); PK4(p1, 0, pa2); PK4(p1, 8, pa3);
#undef PK4
}
__device__ __forceinline__ void qkt(f32x16& p0, f32x16& p1, const LAS char* Ks, const LAS char* KRs, const bf16x8* qr, const LAS char* qrl, int r32, int hi) {
  p0 = f32x16{}; p1 = f32x16{};
#pragma unroll
  for (int d0 = 0; d0 < 8; ++d0) { const int cb = (d0 * 16 + hi * 8) * 2;
    bf16x8 b0 = *(const LAS bf16x8*)(Ks + KSWZ(r32, cb));
    bf16x8 b1 = *(const LAS bf16x8*)(Ks + KSWZ(32 + r32, cb));
    const bf16x8 qq = qr[d0];
    p0 = __builtin_amdgcn_mfma_f32_32x32x16_bf16(b0, qq, p0, 0, 0, 0);
    p1 = __builtin_amdgcn_mfma_f32_32x32x16_bf16(b1, qq, p1, 0, 0, 0); }
#pragma unroll
  for (int d0 = 0; d0 < 4; ++d0) { const int cb = (d0 * 16 + hi * 8) * 2;
    bf16x8 b0 = *(const LAS bf16x8*)(KRs + KRSWZ(r32, cb));
    bf16x8 b1 = *(const LAS bf16x8*)(KRs + KRSWZ(32 + r32, cb));
    const bf16x8 qq = *(const LAS bf16x8*)(qrl + d0 * 1024);
    p0 = __builtin_amdgcn_mfma_f32_32x32x16_bf16(b0, qq, p0, 0, 0, 0);
    p1 = __builtin_amdgcn_mfma_f32_32x32x16_bf16(b1, qq, p1, 0, 0, 0); }
}
__device__ __forceinline__ int v_st(int k, int c) { const int kk = (k & ~0xC) | ((k & 4) << 1) | ((k & 8) >> 1); return ((kk >> 3) * 4 + (c >> 5)) * 512 + ((kk & 7) * 32 + (c & 31)) * 2; }
__device__ __forceinline__ int v_rd_base(int lane) { return ((lane & 3) << 3) | (((lane >> 2) & 3) << 6) | (((lane >> 4) & 1) << 5) | (((lane >> 5) & 1) << 8); }
constexpr int v_rd_off(int d0, int ks, int half) { return d0 * 512 + ks * 4096 + half * 2048; }
template <int OFF> __device__ __forceinline__ s16x4 tr_read(int vb) {
  s16x4 r; asm volatile("ds_read_b64_tr_b16 %0, %1 offset:%2" : "=&v"(r) : "v"(vb), "i"(OFF) : "memory"); return r;
}
template <int D0> __device__ __forceinline__ void pv_one(f32x16& od, int vb, bf16x8 pa0, bf16x8 pa1, bf16x8 pa2, bf16x8 pa3) {
  const s16x4 l0 = tr_read<v_rd_off(D0, 0, 0)>(vb), h0 = tr_read<v_rd_off(D0, 0, 1)>(vb), l1 = tr_read<v_rd_off(D0, 1, 0)>(vb), h1 = tr_read<v_rd_off(D0, 1, 1)>(vb);
  const s16x4 l2 = tr_read<v_rd_off(D0, 2, 0)>(vb), h2 = tr_read<v_rd_off(D0, 2, 1)>(vb), l3 = tr_read<v_rd_off(D0, 3, 0)>(vb), h3 = tr_read<v_rd_off(D0, 3, 1)>(vb);
  asm volatile("s_waitcnt lgkmcnt(0)" ::: "memory"); SBAR();
#define PK(L, H) (bf16x8){L[0], L[1], L[2], L[3], H[0], H[1], H[2], H[3]}
  od = __builtin_amdgcn_mfma_f32_32x32x16_bf16(pa0, PK(l0, h0), od, 0, 0, 0);
  od = __builtin_amdgcn_mfma_f32_32x32x16_bf16(pa1, PK(l1, h1), od, 0, 0, 0);
  od = __builtin_amdgcn_mfma_f32_32x32x16_bf16(pa2, PK(l2, h2), od, 0, 0, 0);
  od = __builtin_amdgcn_mfma_f32_32x32x16_bf16(pa3, PK(l3, h3), od, 0, 0, 0);
#undef PK
}
__device__ __forceinline__ void pv_d0(f32x16* o, int vb, bf16x8 pa0, bf16x8 pa1, bf16x8 pa2, bf16x8 pa3) {
  pv_one<0>(o[0], vb, pa0, pa1, pa2, pa3); pv_one<1>(o[1], vb, pa0, pa1, pa2, pa3); pv_one<2>(o[2], vb, pa0, pa1, pa2, pa3); pv_one<3>(o[3], vb, pa0, pa1, pa2, pa3);
}

#define EX2(v) __builtin_amdgcn_exp2f(v)
#define PK4F(P, BASE, OUT) do { unsigned a0 = cvt_pk_bf16(P[BASE + 0], P[BASE + 1]), a1 = cvt_pk_bf16(P[BASE + 2], P[BASE + 3]);   \
    unsigned b0 = cvt_pk_bf16(P[BASE + 4], P[BASE + 5]), b1 = cvt_pk_bf16(P[BASE + 6], P[BASE + 7]);                              \
    auto r0 = __builtin_amdgcn_permlane32_swap(a0, b0, false, false); auto r1 = __builtin_amdgcn_permlane32_swap(a1, b1, false, false); \
    u32x4 w = {r0[0], r1[0], r0[1], r1[1]}; OUT = *reinterpret_cast<bf16x8*>(&w); } while (0)
__device__ __forceinline__ void qkt_fin(f32x16& c0, f32x16& c1, const LAS char* Ks, const LAS char* KRs, const bf16x8* qr, const LAS char* qrl, int r32, int hi,
                                        f32x16& p0, f32x16& p1, float alpha, float& l_reg, bf16x8& pa0, bf16x8& pa1, bf16x8& pa2, bf16x8& pa3) {
  c0 = f32x16{}; c1 = f32x16{};
  bf16x8 ka[3][2], qa[3]; float ps = 0.f;
#define KRD(D0) do { constexpr int s_ = (D0) % 3; if ((D0) < 8) { const int cb_ = ((D0) * 16 + hi * 8) * 2; \
      ka[s_][0] = *(const LAS bf16x8*)(Ks + KSWZ(r32, cb_)); ka[s_][1] = *(const LAS bf16x8*)(Ks + KSWZ(32 + r32, cb_)); } \
    else { const int cb_ = (((D0) - 8) * 16 + hi * 8) * 2; \
      ka[s_][0] = *(const LAS bf16x8*)(KRs + KRSWZ(r32, cb_)); ka[s_][1] = *(const LAS bf16x8*)(KRs + KRSWZ(32 + r32, cb_)); qa[s_] = *(const LAS bf16x8*)(qrl + ((D0) - 8) * 1024); } } while (0)
#define QMM(D0) do { constexpr int s_ = (D0) % 3; const bf16x8 qq_ = (D0) < 8 ? qr[(D0) & 7] : qa[s_]; \
    c0 = __builtin_amdgcn_mfma_f32_32x32x16_bf16(ka[s_][0], qq_, c0, 0, 0, 0); c1 = __builtin_amdgcn_mfma_f32_32x32x16_bf16(ka[s_][1], qq_, c1, 0, 0, 0); \
    if ((D0) + 3 < 12) { KRD((D0) + 3); } } while (0)
#define E2(K) do { p1[2 * (K)] = EX2(p1[2 * (K)]); p1[2 * (K) + 1] = EX2(p1[2 * (K) + 1]); } while (0)
#define SUM8(P, B) do { ps += ((P[B] + P[B + 1]) + (P[B + 2] + P[B + 3])) + ((P[B + 4] + P[B + 5]) + (P[B + 6] + P[B + 7])); } while (0)
  KRD(0); KRD(1); KRD(2); SBAR();
  QMM(0);  E2(0); PK4F(p0, 0, pa0); SBAR();
  QMM(1);  E2(1); PK4F(p0, 8, pa1); SBAR();
  QMM(2);  E2(2); SUM8(p0, 0); SBAR();
  QMM(3);  E2(3); SUM8(p0, 8); SBAR();
  QMM(4);  E2(4); SUM8(p1, 0); SBAR();
  QMM(5);  E2(5); PK4F(p1, 0, pa2); SBAR();
  QMM(6);  E2(6); SBAR();
  QMM(7);  E2(7); SBAR();
  QMM(8);  SUM8(p1, 8); SBAR();
  QMM(9);  PK4F(p1, 8, pa3); SBAR();
  QMM(10); { auto rr = __builtin_amdgcn_permlane32_swap(__float_as_uint(ps), __float_as_uint(ps), false, false); ps = __uint_as_float(rr[0]) + __uint_as_float(rr[1]); }
           l_reg = l_reg * alpha + ps; SBAR();
  QMM(11); SBAR();
#undef KRD
#undef QMM
#undef E2
#undef SUM8
}
__device__ __forceinline__ void pv_part(f32x16* o, int vb, bf16x8 pa0, bf16x8 pa1, bf16x8 pa2, bf16x8 pa3, f32x16& c0, f32x16& c1, float& m_reg, float& mn, float& alpha) {
  constexpr float C = SCALE * 1.4426950408889634f;
  s16x4 l0, h0, l1, h1, l2, h2, l3, h3;
#define VRD(D0) do { l0 = tr_read<v_rd_off(D0, 0, 0)>(vb); h0 = tr_read<v_rd_off(D0, 0, 1)>(vb); l1 = tr_read<v_rd_off(D0, 1, 0)>(vb); h1 = tr_read<v_rd_off(D0, 1, 1)>(vb); \
    l2 = tr_read<v_rd_off(D0, 2, 0)>(vb); h2 = tr_read<v_rd_off(D0, 2, 1)>(vb); l3 = tr_read<v_rd_off(D0, 3, 0)>(vb); h3 = tr_read<v_rd_off(D0, 3, 1)>(vb); } while (0)
#define PKV(L, H) (bf16x8){L[0], L[1], L[2], L[3], H[0], H[1], H[2], H[3]}
#define VMM(D0) do { asm volatile("s_waitcnt lgkmcnt(0)" ::: "memory"); SBAR(); \
    o[D0] = __builtin_amdgcn_mfma_f32_32x32x16_bf16(pa0, PKV(l0, h0), o[D0], 0, 0, 0); o[D0] = __builtin_amdgcn_mfma_f32_32x32x16_bf16(pa1, PKV(l1, h1), o[D0], 0, 0, 0); \
    o[D0] = __builtin_amdgcn_mfma_f32_32x32x16_bf16(pa2, PKV(l2, h2), o[D0], 0, 0, 0); o[D0] = __builtin_amdgcn_mfma_f32_32x32x16_bf16(pa3, PKV(l3, h3), o[D0], 0, 0, 0); SBAR(); } while (0)
  VRD(0);
  VMM(0); VRD(1);
  float mnC;
  { float pmax = c0[0];
#pragma unroll
    for (int r = 1; r < 16; ++r) pmax = fmaxf(pmax, c0[r]);
#pragma unroll
    for (int r = 0; r < 16; ++r) pmax = fmaxf(pmax, c1[r]);
    { auto rr = __builtin_amdgcn_permlane32_swap(__float_as_uint(pmax), __float_as_uint(pmax), false, false); pmax = fmaxf(__uint_as_float(rr[0]), __uint_as_float(rr[1])); }
    const bool need = !__all(pmax - m_reg <= THR / SCALE);
    mn = need ? fmaxf(m_reg, pmax) : m_reg; alpha = need ? EX2((m_reg - mn) * C) : 1.f; m_reg = mn; mnC = -mn * C; asm volatile("" : "+v"(mnC), "+v"(alpha)); }
  SBAR();
  VMM(1); VRD(2);
#pragma unroll
  for (int r = 0; r < 16; ++r) c0[r] = fmaf(c0[r], C, mnC);
#pragma unroll
  for (int r = 0; r < 8; ++r) c0[r] = EX2(c0[r]);
  asm volatile("" : "+v"(c0));
  SBAR();
  VMM(2); VRD(3);
#pragma unroll
  for (int r = 0; r < 16; ++r) c1[r] = fmaf(c1[r], C, mnC);
#pragma unroll
  for (int r = 8; r < 16; ++r) c0[r] = EX2(c0[r]);
  asm volatile("" : "+v"(c0), "+v"(c1));
  SBAR();
  VMM(3);
#undef VRD
#undef PKV
#undef VMM
}
__device__ __forceinline__ void attn_unit(int b, int h, int qb, const bf16_t* __restrict__ Q, const bf16_t* __restrict__ KV, const bf16_t* __restrict__ KR,
                                          const float* __restrict__ gmix, bf16_t* __restrict__ MIXN, LAS char* lds) {
  const int tid = otid(), wid = tid >> 6, lane = tid & 63, r32 = lane & 31, hi = lane >> 5;
  LAS char* V_lds = lds + OFF_V; LAS char* K_lds = lds + OFF_K; LAS char* KR_lds = lds + OFF_KR;
  LAS float* ws = (LAS float*)(lds + OFF_WS) + wid * 64; LAS float* li_l = ws; LAS float* al_l = ws + 32;
  float m_reg = -1e30f, l_reg = 0; f32x16 o[4] = {}; bf16x8 qr[8];
  LAS char* qrl = lds + OFF_QR + wid * 4096 + lane * 16;
  const long qrow0 = (long)b * SEQ + qb * 256 + wid * QBLK;
  const bf16_t* Qw = Q + (qrow0 + r32) * QW + h * DQK + hi * 8;
#pragma unroll
  for (int d0 = 0; d0 < 8; ++d0) qr[d0] = __builtin_nontemporal_load((const bf16x8*)(Qw + d0 * 16));
#pragma unroll
  for (int d0 = 0; d0 < 4; ++d0) *(LAS bf16x8*)(qrl + d0 * 1024) = *(const bf16x8*)(Qw + (8 + d0) * 16);
  const int wu = __builtin_amdgcn_readfirstlane(wid);
  const int vb0 = (int)(uintptr_t)V_lds + v_rd_base(lane);
  const bf16_t* Kh = KV + h * 256;
  unsigned offK[2], offV[2], offR;
#pragma unroll
  for (int i = 0; i < 2; ++i) { const int o = (wu * 2 + i) * 1024 + lane * 16;
    { const int row = o >> 8, cb = (o & 255) ^ ((row & 7) << 4); offK[i] = (unsigned)(row * KVW * 2 + cb); }
    { const int sub = o >> 9, kk = (sub >> 2) * 8 + ((o & 511) >> 6), col = (sub & 3) * 32 + ((o & 63) >> 1), key = (kk & ~0xC) | ((kk & 4) << 1) | ((kk & 8) >> 1);
      offV[i] = (unsigned)(key * KVW * 2 + col * 2 + 256); } }
  { const int o = wu * 1024 + lane * 16, row = o >> 7, cb = (o & 127) ^ ((row & 7) << 4); offR = (unsigned)(row * ROPE * 2 + cb); }
#define ROWB(j) ((j) < 32 ? (long)b * SEQ + (j) * 64 : (long)ML + b * CTXL + ((j) - 32) * 64)
#define DMA_TILE(j, slot) do { const long rb_ = ROWB(j); const char* kb_ = (const char*)(Kh + rb_ * KVW); const char* rbp_ = (const char*)(KR + rb_ * ROPE); \
    _Pragma("unroll") for (int i_ = 0; i_ < 2; ++i_) { \
      __builtin_amdgcn_global_load_lds((const unsigned*)(kb_ + offK[i_]), (LAS unsigned*)(K_lds + (slot) * SHM_K + (wu * 2 + i_) * 1024), 16, 0, 0); \
      __builtin_amdgcn_global_load_lds((const unsigned*)(kb_ + offV[i_]), (LAS unsigned*)(V_lds + (slot) * SHM_V + (wu * 2 + i_) * 1024), 16, 0, 0); } \
    __builtin_amdgcn_global_load_lds((const unsigned*)(rbp_ + offR), (LAS unsigned*)(KR_lds + (slot) * SHM_KR + wu * 1024), 16, 0, 0); } while (0)
#define DMA_WAIT() asm volatile("s_waitcnt vmcnt(0)" ::: "memory")
#define RESC(a) do { if (__any((a) < 1.f)) { if (hi == 0) al_l[r32] = (a); asm volatile("s_waitcnt lgkmcnt(0)" ::: "memory"); \
    _Pragma("unroll") for (int d = 0; d < 4; ++d) _Pragma("unroll") for (int r = 0; r < 16; ++r) o[d][r] *= al_l[crow(r, hi)]; } } while (0)
  f32x16 pA0, pA1, pB0, pB1; float mnA, mnB, alA, alB; bf16x8 pa0, pa1, pa2, pa3; constexpr int NT = 36;
  DMA_TILE(0, 0); DMA_TILE(1, 1); DMA_WAIT(); __syncthreads();
  qkt(pA0, pA1, K_lds, KR_lds, qr, qrl, r32, hi); partialSM(pA0, pA1, m_reg, mnA, alA);
  int sK = 1, sV = 0, sW = 2;
#define ITER(PC0, PC1, mnC, alC, PP0, PP1, alP, jj, DOLOAD) do { \
    if (DOLOAD) { DMA_TILE((jj) + 1, sW); } \
    SBAR(); qkt_fin(PC0, PC1, K_lds + sK * SHM_K, KR_lds + sK * SHM_KR, qr, qrl, r32, hi, PP0, PP1, alP, l_reg, pa0, pa1, pa2, pa3); SBAR(); \
    pv_part(o, vb0 + sV * SHM_V, pa0, pa1, pa2, pa3, PC0, PC1, m_reg, mnC, alC); \
    RESC(alC); DMA_WAIT(); __syncthreads(); \
    { const int t_ = sV; sV = sK; sK = sW; sW = t_; } } while (0)
  for (int j = 1; j + 1 < NT; j += 2) {
    ITER(pB0, pB1, mnB, alB, pA0, pA1, alA, j, true);
    ITER(pA0, pA1, mnA, alA, pB0, pB1, alB, j + 1, true);
  }
  ITER(pB0, pB1, mnB, alB, pA0, pA1, alA, NT - 1, false);
  finishSM(pB0, pB1, alB, l_reg, pa0, pa1, pa2, pa3); SBAR();
  pv_d0(o, vb0 + sV * SHM_V, pa0, pa1, pa2, pa3);
#undef ITER
  if (hi == 0) li_l[r32] = l_reg; asm volatile("s_waitcnt lgkmcnt(0)" ::: "memory");
  float rli[16];
#pragma unroll
  for (int r = 0; r < 16; ++r) rli[r] = __builtin_amdgcn_rcpf(li_l[crow(r, hi)]);
  __syncthreads();
  constexpr int OST = 132;
  LAS float* st = (LAS float*)lds + wid * (32 * OST);
#pragma unroll
  for (int r = 0; r < 16; ++r) { const int orow = crow(r, hi);
#pragma unroll
    for (int d0 = 0; d0 < 4; ++d0) st[orow * OST + d0 * 32 + r32] = o[d0][r] * rli[r]; }
  asm volatile("s_waitcnt lgkmcnt(0)" ::: "memory");
  { int lane2 = lane; asm volatile("" : "+v"(lane2));
    const int row = lane2 >> 1, half = lane2 & 1; const LAS float* rp = st + row * OST + half * 64;
    f32x4 v[16]; float ss = 0.f;
#pragma unroll
    for (int i = 0; i < 16; ++i) { v[i] = *(const LAS f32x4*)(rp + 4 * i); ss += (v[i][0] * v[i][0] + v[i][1] * v[i][1]) + (v[i][2] * v[i][2] + v[i][3] * v[i][3]); }
    ss += __shfl_xor(ss, 1);
    const float rs = rsqrtf(ss * (1.0f / 128.0f) + EPS);
    const float* gp = gmix + h * 128 + half * 64;
    bf16_t* op = MIXN + (qrow0 + row) * DM + h * 128 + half * 64;
#pragma unroll
    for (int i = 0; i < 8; ++i) { const f32x4 g0 = *(const f32x4*)(gp + 8 * i), g1 = *(const f32x4*)(gp + 8 * i + 4); const f32x4 a = v[2 * i] * rs * g0, c = v[2 * i + 1] * rs * g1;
      u32x4 w; w.x = cvt_pk_bf16(a[0], a[1]); w.y = cvt_pk_bf16(a[2], a[3]); w.z = cvt_pk_bf16(c[0], c[1]); w.w = cvt_pk_bf16(c[2], c[3]);
      *(u32x4*)(op + 8 * i) = w; } }
  asm volatile("s_waitcnt lgkmcnt(0)" ::: "memory");
  __syncthreads();
#undef ROWB
#undef DMA_TILE
#undef DMA_WAIT
#undef RESC
}
#undef SBAR
}

struct Params {
    const float *x, *c, *ctx, *c_ctx, *w_ada, *b_ada, *g_mix_norm, *w_in, *g_q_a, *w_q_b, *g_kv_a, *w_kv_b,
                *conv_w, *conv_b, *g_mix_out, *w_out, *g_ffn_norm, *w_up, *ffn_conv_w, *ffn_conv_b, *w_down, *g_final;
    float* out; unsigned char* ws;
};

__device__ __forceinline__ unsigned f2bf(float f) { unsigned u = __float_as_uint(f); return (u + 0x7fffu + ((u >> 16) & 1u)) >> 16; }
__device__ __forceinline__ unsigned pk2(float lo, float hi) { return f2bf(lo) | (f2bf(hi) << 16); }
__device__ __forceinline__ void p0_transpose_item(const float* W, int K, int N, bf16_t* WT, LAS float* scr, int item, int lane, bool upmap = false) {
    const int nblk = N / 64, kb = item / nblk, nb = item % nblk, k0 = 64 * kb, n0 = 64 * nb;
    const int n0o = !upmap ? n0 : (n0 < FFN ? (n0 >> 7) * 256 + (n0 & 127) : ((n0 - FFN) >> 7) * 256 + 128 + ((n0 - FFN) & 127));
    const int lr = lane >> 4, lc = (lane & 15) * 4;
    const float* wp = W + (size_t)(k0 + lr) * N + n0 + lc;
    f32x4 v[16];
#pragma unroll
    for (int i = 0; i < 16; ++i) v[i] = __builtin_nontemporal_load((const f32x4*)(wp + (size_t)(4 * i) * N));
#pragma unroll
    for (int i = 0; i < 16; ++i) { LAS float* d = scr + (4 * i + lr) * 65 + lc; d[0] = v[i][0]; d[1] = v[i][1]; d[2] = v[i][2]; d[3] = v[i][3]; }
    asm volatile("s_waitcnt lgkmcnt(0)" ::: "memory");
    const int c = lane & 7;
#pragma unroll
    for (int j = 0; j < 8; ++j) { const int n = (lane >> 3) + 8 * j; const LAS float* s = scr + (8 * c) * 65 + n;
        u32x4 o; o.x = cvt_pk_bf16(s[0 * 65], s[1 * 65]); o.y = cvt_pk_bf16(s[2 * 65], s[3 * 65]); o.z = cvt_pk_bf16(s[4 * 65], s[5 * 65]); o.w = cvt_pk_bf16(s[6 * 65], s[7 * 65]);
        if (upmap) __builtin_nontemporal_store(o, (u32x4*)(WT + (size_t)(n0o + n) * K + k0 + 8 * c)); else *(u32x4*)(WT + (size_t)(n0o + n) * K + k0 + 8 * c) = o; }
    asm volatile("s_waitcnt lgkmcnt(0)" ::: "memory");
}
constexpr int I_IN = 32 * (INC / 64), I_QB = (QRANK / 64) * (QW / 64), I_KVB = (KVRANK / 64) * (KVW / 64), I_OUT = 32 * (DM / 64), I_UP = 32 * (FFN2 / 64), I_DOWN = (FFN / 64) * (DM / 64);
constexpr int I_TOTAL = I_IN + I_QB + I_KVB + I_OUT + I_UP + I_DOWN;
constexpr int I_P0 = I_TOTAL - I_DOWN;
__device__ __forceinline__ void p0_item(const Params& p, int it, LAS float* scr, int lane) {
    unsigned char* ws = p.ws; int r = it;
    if (r < I_UP) { p0_transpose_item(p.w_up, DM, FFN2, (bf16_t*)(ws + WS_WUP), scr, r, lane, true); return; } r -= I_UP;
    if (r < I_IN) { p0_transpose_item(p.w_in, DM, INC, (bf16_t*)(ws + WS_WIN), scr, r, lane); return; } r -= I_IN;
    if (r < I_OUT) { p0_transpose_item(p.w_out, DM, DM, (bf16_t*)(ws + WS_WOUT), scr, r, lane); return; } r -= I_OUT;
    if (r < I_QB) { p0_transpose_item(p.w_q_b, QRANK, QW, (bf16_t*)(ws + WS_WQB), scr, r, lane); return; } r -= I_QB;
    p0_transpose_item(p.w_kv_b, KVRANK, KVW, (bf16_t*)(ws + WS_WKVB), scr, r, lane);
}
__device__ __forceinline__ void phase_prologue(const Params& p, LAS unsigned char* lds, int G) {
    const int tid = otid(), lane = tid & 63, wave = __builtin_amdgcn_readfirstlane(tid >> 6), blk = blockIdx.x;
    const int gw = blk * NWAVES + wave, NGW = G * NWAVES, gtid = blk * NTHR + tid, NGT = G * NTHR;
    unsigned char* ws = p.ws;
    for (int idx = gtid; idx < SEQ * 32; idx += NGT) { const int t = idx >> 5, i = idx & 31; const float pos = (float)((i < 16) ? (t >> 6) : (t & 63));
        const float inv = exp2f(-(float)(i & 15) * (13.287712379549449f / 16.0f)); const float ang = pos * inv;
        ((f32x2*)(ws + WS_ROPE))[idx] = (f32x2){cosf(ang), sinf(ang)}; }
    for (int i = gtid; i < (INP - INC) * DM / 8; i += NGT) ((u32x4*)((bf16_t*)(ws + WS_WIN) + (size_t)INC * DM))[i] = (u32x4){0u, 0u, 0u, 0u};
    const int NGEMV = 192 < G ? 192 : 0;
    if (blk < NGEMV) {
        const int nc = blk % 48, ksc = blk / 48, k0 = ksc * 512 + wave * 64;
        float sv[5];
#pragma unroll
        for (int r = 0; r < 5; ++r) { const float cvv = (r < 4) ? p.c[r * DM + k0 + lane] : p.c_ctx[k0 + lane]; sv[r] = silu_f(cvv); }
        f32x4 acc[5];
#pragma unroll
        for (int r = 0; r < 5; ++r) acc[r] = (f32x4){0.f, 0.f, 0.f, 0.f};
        const float* wp = p.w_ada + (size_t)k0 * 12288 + nc * 256 + 4 * lane;
#pragma unroll 16
        for (int kk = 0; kk < 64; ++kk) { const f32x4 wv = __builtin_nontemporal_load((const f32x4*)(wp + (size_t)kk * 12288));
#pragma unroll
            for (int r = 0; r < 5; ++r) { const float s = __uint_as_float(__builtin_amdgcn_readlane(__float_as_uint(sv[r]), kk)); acc[r] += wv * s; } }
        LAS float* red = (LAS float*)lds;
#pragma unroll
        for (int r = 0; r < 5; ++r)
#pragma unroll
            for (int j = 0; j < 4; ++j) red[(wave * 20 + r * 4 + j) * 64 + lane] = acc[r][j];
        __syncthreads();
        float* mod = (float*)(ws + WS_MOD);
        for (int o = tid; o < 1280; o += NTHR) { const int r = o >> 8, col = o & 255, l = col >> 2, j = col & 3; float s = 0.f;
#pragma unroll
            for (int w = 0; w < 8; ++w) s += red[(w * 20 + r * 4 + j) * 64 + l];
            if (ksc == 0) s += p.b_ada[nc * 256 + col];
            __hip_atomic_fetch_add(mod + r * 12288 + nc * 256 + col, s, __ATOMIC_RELAXED, __HIP_MEMORY_SCOPE_AGENT); }
        __syncthreads();
    }
    LAS float* scr = (LAS float*)(lds + wave * 16640);
    const int nfree = (G - NGEMV) * NWAVES; int head = nfree * 4; if (head > I_P0) head = I_P0;
    if (blk >= NGEMV) { const int fw = (blk - NGEMV) * NWAVES + wave;
        for (int i = 0; i < 4; ++i) { const int it = fw * 4 + i; if (it < head) p0_item(p, it, scr, lane); } }
    for (int it = head + gw; it < I_P0; it += NGW) p0_item(p, it, scr, lane);
}

__device__ __forceinline__ void phase_normmod(const float* xl, const float* xc, const float* g, const float* mod, int sh_chunk, bf16_t* H, int nrows, int G) {
    const int tid = otid(), lane = tid & 63, wave = tid >> 6; const int gw = blockIdx.x * NWAVES + wave, NGW = G * NWAVES;
    const f32x4* gp = (const f32x4*)g;
    for (int row = gw; row < nrows; row += 2 * NGW) {
        const int row2 = row + NGW; const bool has2 = row2 < nrows;
        const float* xr = row < ML ? xl + (size_t)row * DM : xc + (size_t)(row - ML) * DM;
        const float* xr2 = has2 ? (row2 < ML ? xl + (size_t)row2 * DM : xc + (size_t)(row2 - ML) * DM) : xr;
        f32x4 v[8], w[8]; float ss = 0.f, ss2 = 0.f;
#pragma unroll
        for (int j = 0; j < 8; ++j) v[j] = __builtin_nontemporal_load((const f32x4*)xr + lane + 64 * j);
#pragma unroll
        for (int j = 0; j < 8; ++j) w[j] = __builtin_nontemporal_load((const f32x4*)xr2 + lane + 64 * j);
#pragma unroll
        for (int j = 0; j < 8; ++j) { ss += (v[j][0] * v[j][0] + v[j][1] * v[j][1]) + (v[j][2] * v[j][2] + v[j][3] * v[j][3]); ss2 += (w[j][0] * w[j][0] + w[j][1] * w[j][1]) + (w[j][2] * w[j][2] + w[j][3] * w[j][3]); }
        ss = wave_sum(ss); ss2 = wave_sum(ss2);
        { const int mr = row < ML ? (row >> 11) : 4; const float rstd = rsqrtf(ss * (1.0f / DM) + EPS);
          const f32x4* shp = (const f32x4*)(mod + (size_t)mr * 12288 + sh_chunk * DM); const f32x4* scp = shp + DM / 4; u32x2* op = (u32x2*)(H + (size_t)row * DM);
#pragma unroll
          for (int j = 0; j < 8; ++j) { const f32x4 gg = gp[lane + 64 * j], s4 = scp[lane + 64 * j], h4 = shp[lane + 64 * j];
            const f32x4 y = v[j] * rstd * gg * (s4 + 1.0f) + h4; u32x2 o; o.x = cvt_pk_bf16(y[0], y[1]); o.y = cvt_pk_bf16(y[2], y[3]); op[lane + 64 * j] = o; } }
        if (has2) { const int mr = row2 < ML ? (row2 >> 11) : 4; const float rstd = rsqrtf(ss2 * (1.0f / DM) + EPS);
          const f32x4* shp = (const f32x4*)(mod + (size_t)mr * 12288 + sh_chunk * DM); const f32x4* scp = shp + DM / 4; u32x2* op = (u32x2*)(H + (size_t)row2 * DM);
#pragma unroll
          for (int j = 0; j < 8; ++j) { const f32x4 gg = gp[lane + 64 * j], s4 = scp[lane + 64 * j], h4 = shp[lane + 64 * j];
            const f32x4 y = w[j] * rstd * gg * (s4 + 1.0f) + h4; u32x2 o; o.x = cvt_pk_bf16(y[0], y[1]); o.y = cvt_pk_bf16(y[2], y[3]); op[lane + 64 * j] = o; } }
    }
}
__device__ __forceinline__ void phase_final(float* xio, const float* g, int G) {
    const int tid = otid(), lane = tid & 63, wave = tid >> 6; const int gw = blockIdx.x * NWAVES + wave, NGW = G * NWAVES;
    for (int row = gw; row < ML; row += NGW) {
        f32x4* xr = (f32x4*)(xio + (size_t)row * DM); const f32x4* gp = (const f32x4*)g;
        f32x4 v[8]; float ss = 0.f;
#pragma unroll
        for (int j = 0; j < 8; ++j) { v[j] = xr[lane + 64 * j]; ss += (v[j][0] * v[j][0] + v[j][1] * v[j][1]) + (v[j][2] * v[j][2] + v[j][3] * v[j][3]); }
        ss = wave_sum(ss); const float rstd = rsqrtf(ss * (1.0f / DM) + EPS);
#pragma unroll
        for (int j = 0; j < 8; ++j) xr[lane + 64 * j] = v[j] * rstd * gp[lane + 64 * j];
    }
}

__device__ __forceinline__ void phase_prep(const Params& p, int G) {
    const int tid = otid(), lane = tid & 63, wave = tid >> 6; const int gw = blockIdx.x * NWAVES + wave, NGW = G * NWAVES;
    unsigned char* ws = p.ws;
    const bf16_t* P = (const bf16_t*)(ws + WS_P); bf16_t* QN = (bf16_t*)(ws + WS_QN); bf16_t* KVN = (bf16_t*)(ws + WS_KVN); bf16_t* KR = (bf16_t*)(ws + WS_KR); bf16_t* MIXN = (bf16_t*)(ws + WS_MIXN);
    const f32x2* tab = (const f32x2*)(ws + WS_ROPE);
    const float* SL = (const float*)(ws + WS_SLAB);
    for (int row = gw; row < MT; row += NGW) {
        const bf16_t* pr = P + (size_t)row * INP; const bool latent = row < ML;
        if (latent) { float f[8]; unpack8(*(const u32x4*)(pr + C_QA + 8 * lane), f); float ss = 0.f;
#pragma unroll
            for (int i = 0; i < 8; ++i) ss += f[i] * f[i];
            ss = wave_sum(ss); const float rs = rsqrtf(ss * (1.0f / QRANK) + EPS);
            const f32x4 g0 = *(const f32x4*)(p.g_q_a + 8 * lane), g1 = *(const f32x4*)(p.g_q_a + 8 * lane + 4);
#pragma unroll
            for (int i = 0; i < 4; ++i) { f[i] *= rs * g0[i]; f[4 + i] *= rs * g1[i]; }
            *(u32x4*)(QN + (size_t)row * QRANK + 8 * lane) = pack8(f); }
        float f[8];
#pragma unroll
        for (int i = 0; i < 8; ++i) f[i] = 0.f;
        if (lane < 40) {
            if (latent) unpack8(*(const u32x4*)(pr + C_KVA + 8 * lane), f);
            else { const float* sp = SL + (size_t)(row - ML) * 512 + 8 * lane;
#pragma unroll
                for (int k = 0; k < 8; ++k) { const f32x4 a = *(const f32x4*)(sp + (size_t)k * (1024 * 512)), b = *(const f32x4*)(sp + (size_t)k * (1024 * 512) + 4);
#pragma unroll
                    for (int i = 0; i < 4; ++i) { f[i] += a[i]; f[4 + i] += b[i]; } } } }
        float ss = 0.f;
        if (lane < 32) {
#pragma unroll
            for (int i = 0; i < 8; ++i) ss += f[i] * f[i]; }
        ss = wave_sum(ss); const float rs = rsqrtf(ss * (1.0f / KVRANK) + EPS);
        if (lane < 32) { const f32x4 g0 = *(const f32x4*)(p.g_kv_a + 8 * lane), g1 = *(const f32x4*)(p.g_kv_a + 8 * lane + 4);
#pragma unroll
            for (int i = 0; i < 4; ++i) { f[i] *= rs * g0[i]; f[4 + i] *= rs * g1[i]; }
            *(u32x4*)(KVN + (size_t)row * KVRANK + 8 * lane) = pack8(f); }
        else if (lane < 40) { const int l8 = lane - 32;
            if (latent) { const f32x2* tp = tab + (size_t)(row & (SEQ - 1)) * 32 + 4 * l8;
#pragma unroll
                for (int q = 0; q < 4; ++q) { const f32x2 cs = tp[q]; const float a = f[2 * q], b = f[2 * q + 1]; f[2 * q] = a * cs[0] - b * cs[1]; f[2 * q + 1] = a * cs[1] + b * cs[0]; } }
            *(u32x4*)(KR + (size_t)row * ROPE + 8 * l8) = pack8(f); }
    }
    for (int task = gw; task < ML / 4; task += NGW) {
        const int r0 = task * 4;
        float w0[2][8], w1[2][8], w2[2][8], bb[2][8], gg[2][8];
#pragma unroll
        for (int j = 0; j < 2; ++j) { const int ch = 8 * lane + 512 * j;
#pragma unroll
            for (int h = 0; h < 2; ++h) { const f32x4 a = *(const f32x4*)(p.conv_w + ch + 4 * h), b = *(const f32x4*)(p.conv_w + CONVW + ch + 4 * h), c = *(const f32x4*)(p.conv_w + 2 * CONVW + ch + 4 * h),
                    d = *(const f32x4*)(p.conv_b + ch + 4 * h), e = *(const f32x4*)(p.g_mix_out + 1024 + ch + 4 * h);
#pragma unroll
                for (int i = 0; i < 4; ++i) { w0[j][4 * h + i] = a[i]; w1[j][4 * h + i] = b[i]; w2[j][4 * h + i] = c[i]; bb[j][4 * h + i] = d[i]; gg[j][4 * h + i] = e[i]; } } }
        float zp[2][8], zc[2][8], zn[2][8];
#define ZLOAD(dst, row_, valid_) do { _Pragma("unroll") for (int j = 0; j < 2; ++j) { const int ch = 8 * lane + 512 * j; \
            if (valid_) { float a_[8], b_[8]; unpack8(*(const u32x4*)(P + (size_t)(row_) * INP + C_CC + ch), a_); unpack8(*(const u32x4*)(P + (size_t)(row_) * INP + C_CH + ch), b_); \
                _Pragma("unroll") for (int i = 0; i < 8; ++i) dst[j][i] = a_[i] * b_[i]; } \
            else { _Pragma("unroll") for (int i = 0; i < 8; ++i) dst[j][i] = 0.f; } } } while (0)
        ZLOAD(zp, r0 - 1, ((r0 & (SEQ - 1)) != 0));
        ZLOAD(zc, r0, true);
#pragma unroll
        for (int ii = 0; ii < 4; ++ii) { const int t = r0 + ii;
            ZLOAD(zn, t + 1, ((t & (SEQ - 1)) != SEQ - 1));
#pragma unroll
            for (int j = 0; j < 2; ++j) { const int ch = 8 * lane + 512 * j; float cbv[8], y[8]; unpack8(*(const u32x4*)(P + (size_t)t * INP + C_CB + ch), cbv); float ss = 0.f;
#pragma unroll
                for (int i = 0; i < 8; ++i) { y[i] = cbv[i] * (w0[j][i] * zp[j][i] + w1[j][i] * zc[j][i] + w2[j][i] * zn[j][i] + bb[j][i]); ss += y[i] * y[i]; }
                ss += __shfl_xor(ss, 1); ss += __shfl_xor(ss, 2); ss += __shfl_xor(ss, 4); ss += __shfl_xor(ss, 8);
                const float rs = rsqrtf(ss * (1.0f / 128.0f) + EPS);
#pragma unroll
                for (int i = 0; i < 8; ++i) y[i] *= rs * gg[j][i];
                *(u32x4*)(MIXN + (size_t)t * DM + 1024 + ch) = pack8(y); }
#pragma unroll
            for (int j = 0; j < 2; ++j)
#pragma unroll
                for (int i = 0; i < 8; ++i) { zp[j][i] = zc[j][i]; zc[j][i] = zn[j][i]; } }
#undef ZLOAD
    }
}

__device__ __forceinline__ void phase_act(const Params& p, int G) {
    const int gtid = blockIdx.x * NTHR + otid(), NGT = G * NTHR;
    const bf16_t* U = (const bf16_t*)(p.ws + WS_U); bf16_t* ACT = (bf16_t*)(p.ws + WS_ACT);
    constexpr int NCH = FFN / 8, RB = 16, NTASK = (ML / RB) * NCH;
    for (int task = gtid; task < NTASK; task += NGT) {
        const int chunk = task % NCH, r0 = (task / NCH) * RB, col = chunk * 8;
        float wa[3][8], wg[3][8], ba[8], bg[8];
#pragma unroll
        for (int k = 0; k < 3; ++k)
#pragma unroll
            for (int h = 0; h < 2; ++h) { const f32x4 a = *(const f32x4*)(p.ffn_conv_w + (size_t)k * FFN2 + col + 4 * h), g = *(const f32x4*)(p.ffn_conv_w + (size_t)k * FFN2 + FFN + col + 4 * h);
#pragma unroll
                for (int i = 0; i < 4; ++i) { wa[k][4 * h + i] = a[i]; wg[k][4 * h + i] = g[i]; } }
#pragma unroll
        for (int h = 0; h < 2; ++h) { const f32x4 a = *(const f32x4*)(p.ffn_conv_b + col + 4 * h), g = *(const f32x4*)(p.ffn_conv_b + FFN + col + 4 * h);
#pragma unroll
            for (int i = 0; i < 4; ++i) { ba[4 * h + i] = a[i]; bg[4 * h + i] = g[i]; } }
        float pa[8], pg[8], ca[8], cgv[8], na[8], ng[8];
#define ULOAD(da, dg, row_, valid_) do { if (valid_) { unpack8(*(const u32x4*)(U + (size_t)(row_) * FFN2 + col), da); unpack8(*(const u32x4*)(U + (size_t)(row_) * FFN2 + FFN + col), dg); } \
            else { _Pragma("unroll") for (int i = 0; i < 8; ++i) { da[i] = 0.f; dg[i] = 0.f; } } } while (0)
        ULOAD(pa, pg, r0 - 1, ((r0 & (SEQ - 1)) != 0));
        ULOAD(ca, cgv, r0, true);
#pragma unroll 4
        for (int ii = 0; ii < RB; ++ii) { const int t = r0 + ii;
            ULOAD(na, ng, t + 1, ((t & (SEQ - 1)) != SEQ - 1));
            float y[8];
#pragma unroll
            for (int i = 0; i < 8; ++i) { const float a = wa[0][i] * pa[i] + wa[1][i] * ca[i] + wa[2][i] * na[i] + ba[i]; const float g = wg[0][i] * pg[i] + wg[1][i] * cgv[i] + wg[2][i] * ng[i] + bg[i];
                y[i] = a * silu_f(g); }
            *(u32x4*)(ACT + (size_t)t * FFN + col) = pack8(y);
#pragma unroll
            for (int i = 0; i < 8; ++i) { pa[i] = ca[i]; pg[i] = cgv[i]; ca[i] = na[i]; cgv[i] = ng[i]; } }
#undef ULOAD
    }
}

__device__ __forceinline__ void act_fixup_panel(const Params& p, int pm) {
    const bf16_t* RAW = (const bf16_t*)(p.ws + WS_RAW); bf16_t* ACT = (bf16_t*)(p.ws + WS_ACT);
    constexpr int NCH = FFN / 8;
    for (int chunk = otid(); chunk < NCH; chunk += NTHR) {
        const int col = chunk * 8, tcol = (col >> 7) * 256 + (col & 127);
        float wa[3][8], wg[3][8], ba[8], bg[8];
#pragma unroll
        for (int h = 0; h < 2; ++h) {
#pragma unroll
            for (int k = 0; k < 3; ++k) { const f32x4 a = *(const f32x4*)(p.ffn_conv_w + (size_t)k * FFN2 + col + 4 * h), g = *(const f32x4*)(p.ffn_conv_w + (size_t)k * FFN2 + FFN + col + 4 * h);
#pragma unroll
                for (int i = 0; i < 4; ++i) { wa[k][4 * h + i] = a[i]; wg[k][4 * h + i] = g[i]; } }
            const f32x4 a = *(const f32x4*)(p.ffn_conv_b + col + 4 * h), g = *(const f32x4*)(p.ffn_conv_b + FFN + col + 4 * h);
#pragma unroll
            for (int i = 0; i < 4; ++i) { ba[4 * h + i] = a[i]; bg[4 * h + i] = g[i]; } }
#pragma unroll 2
        for (int rr = 0; rr < 8; ++rr) {
            const int rb = pm * 4 + (rr >> 1), bot = rr & 1, t = rb * 64 + (bot ? 63 : 0);
            const bool has_up = bot || ((rb & 31) != 0), has_dn = !bot || ((rb & 31) != 31);
            const size_t r_up = bot ? (size_t)rb * 4 + 2 : (size_t)(rb - 1) * 4 + 3, r_cu = (size_t)rb * 4 + (bot ? 3 : 0), r_dn = bot ? (size_t)(rb + 1) * 4 + 0 : (size_t)rb * 4 + 1;
            float ua[8], ug[8], ca[8], cg[8], da[8], dg[8];
            if (has_up) { unpack8(*(const u32x4*)(RAW + r_up * FFN2 + tcol), ua); unpack8(*(const u32x4*)(RAW + r_up * FFN2 + tcol + 128), ug); }
            else {
#pragma unroll
                for (int i = 0; i < 8; ++i) { ua[i] = 0.f; ug[i] = 0.f; } }
            unpack8(*(const u32x4*)(RAW + r_cu * FFN2 + tcol), ca); unpack8(*(const u32x4*)(RAW + r_cu * FFN2 + tcol + 128), cg);
            if (has_dn) { unpack8(*(const u32x4*)(RAW + r_dn * FFN2 + tcol), da); unpack8(*(const u32x4*)(RAW + r_dn * FFN2 + tcol + 128), dg); }
            else {
#pragma unroll
                for (int i = 0; i < 8; ++i) { da[i] = 0.f; dg[i] = 0.f; } }
            float y[8];
#pragma unroll
            for (int k = 0; k < 8; ++k) { const float a = wa[0][k] * ua[k] + wa[1][k] * ca[k] + wa[2][k] * da[k] + ba[k]; const float g = wg[0][k] * ug[k] + wg[1][k] * cg[k] + wg[2][k] * dg[k] + bg[k];
                y[k] = a * silu_f(g); }
            *(u32x4*)(ACT + (size_t)t * FFN + col) = pack8(y);
        }
    }
}

#define XB_TMO      128
#define XB_XCNT(j)  (256  + 64 * (j))
#define XB_XSUB(j)  (1280 + 64 * (j))
#define XB_XGEN(j)  (2304 + 64 * (j))
#define XB_TOP      3328
#define XB_TOPGEN   3392
#define XCD_BAR_WORDS 3456
#define XB_SPIN_CAP (1u << 18)
__device__ __forceinline__ unsigned xb_ld(unsigned* p)              { return __hip_atomic_load(p, __ATOMIC_RELAXED, __HIP_MEMORY_SCOPE_AGENT); }
__device__ __forceinline__ unsigned xb_add(unsigned* p, unsigned v) { return __hip_atomic_fetch_add(p, v, __ATOMIC_RELAXED, __HIP_MEMORY_SCOPE_AGENT); }
__device__ __forceinline__ unsigned xb_xcc_id() { return (unsigned)__builtin_amdgcn_s_getreg((3 << 11) | 20) & 0xFu; }
#define XB_SPIN(cond, bar) do { unsigned _sp = 0; while (cond) { __builtin_amdgcn_s_sleep(1); \
    if ((++_sp & 255u) == 0u) { if (xb_ld(&(bar)[XB_TMO])) break; if (_sp > XB_SPIN_CAP) { atomicAdd(&(bar)[XB_TMO], 1u); break; } } } } while (0)
struct XcdBarrier { unsigned* bar; unsigned x; volatile LAS unsigned* st; };
__device__ __forceinline__ XcdBarrier xcd_barrier_post(unsigned* bar, volatile LAS unsigned* st) {
    XcdBarrier b; b.bar = bar; b.x = xb_xcc_id(); b.st = st;
    if (threadIdx.x == 0) (void)xb_add(&bar[XB_XCNT(b.x)], 1u);
    return b;
}
__device__ __forceinline__ void xcd_barrier_complete(unsigned* bar, unsigned x, unsigned& nloc, unsigned& nx) {
    const unsigned G = gridDim.x * gridDim.y * gridDim.z;
    unsigned sum, cnt, mine, sp = 0u;
    for (;;) {
        sum = 0u; cnt = 0u; mine = 0u;
#pragma unroll
        for (unsigned j = 0; j < 16; ++j) { const unsigned c = xb_ld(&bar[XB_XCNT(j)]); sum += c; cnt += (c > 0u) ? 1u : 0u; mine = (j == x) ? c : mine; }
        if (sum == G) break;
        __builtin_amdgcn_s_sleep(1);
        if ((++sp & 255u) == 0u) { if (xb_ld(&bar[XB_TMO])) break; if (sp > XB_SPIN_CAP) { atomicAdd(&bar[XB_TMO], 1u); break; } }
    }
    nloc = mine > 0u ? mine : 1u; nx = cnt > 0u ? cnt : 1u;
}
__device__ __forceinline__ void xcd_barrier(const XcdBarrier& b) {
    asm volatile("s_waitcnt vmcnt(0)" ::: "memory");
    __syncthreads();
    if (threadIdx.x == 0) {
        unsigned* bar = b.bar;
        __builtin_amdgcn_s_waitcnt(0);
        unsigned nloc = b.st[0], nx = b.st[1];
        if (nloc == 0u) { xcd_barrier_complete(bar, b.x, nloc, nx); b.st[0] = nloc; b.st[1] = nx; }
        const unsigned old = xb_add(&bar[XB_XSUB(b.x)], 1u);
        const unsigned gen = old / nloc;
        if (old + 1u == (gen + 1u) * nloc) {
            __builtin_amdgcn_fence(__ATOMIC_RELEASE, "agent");
            asm volatile("s_waitcnt vmcnt(0)" ::: "memory");
            const unsigned og = xb_add(&bar[XB_TOP], 1u);
            const unsigned tg = og / nx;
            if (og + 1u == (tg + 1u) * nx) xb_add(&bar[XB_TOPGEN], 1u);
            else XB_SPIN(xb_ld(&bar[XB_TOPGEN]) == tg, bar);
            __builtin_amdgcn_fence(__ATOMIC_ACQUIRE, "agent");
            xb_add(&bar[XB_XGEN(b.x)], 1u);
            asm volatile("s_waitcnt vmcnt(0)" ::: "memory");
        } else {
            XB_SPIN(xb_ld(&bar[XB_XGEN(b.x)]) == gen, bar);
            __builtin_amdgcn_fence(__ATOMIC_ACQUIRE, "agent");
            asm volatile("s_waitcnt vmcnt(0)" ::: "memory");
        }
    }
    __syncthreads();
}

#ifndef PH_MASK
#define PH_MASK 0xfff
#endif
#define PH(k) ((PH_MASK >> (k)) & 1)
__global__ void __launch_bounds__(NTHR, 2) fwd_megakernel(Params p) {
    extern __shared__ __attribute__((aligned(16))) unsigned char lds_raw[];
    LAS unsigned char* lds = (LAS unsigned char*)lds_raw;
    cg::grid_group grid = cg::this_grid();
    const int G = gridDim.x, blk = blockIdx.x;
    unsigned char* ws = p.ws;
    float* mod = (float*)(ws + WS_MOD);
    volatile LAS unsigned* misc = (volatile LAS unsigned*)(lds + LDS_BYTES - 64);
    if (threadIdx.x < 16) misc[threadIdx.x] = 0u;
    __syncthreads();
    const XcdBarrier xbar = xcd_barrier_post((unsigned*)(ws + WS_BAR), misc);
#define SEAM() xcd_barrier(xbar)

    if (PH(0)) phase_prologue(p, lds, G);
    if (p.ws == nullptr) grid.sync();
    SEAM();
    if (PH(1)) phase_normmod(p.x, p.ctx, p.g_mix_norm, mod, 0, (bf16_t*)(ws + WS_H), MT, G);
    SEAM();
    if (PH(2)) { pg8::Gemm g{(const bf16_t*)(ws + WS_H), (const bf16_t*)(ws + WS_WIN), ML, INP, DM, DM, DM}; pg8::StaticOrder S; S.init(ML, INP, G, blk);
      pg8::EpiBf16 E{(bf16_t*)(ws + WS_P), INP};
      pg8::gemm_phase<pg8::EpiBf16, pg8::StaticOrder, true>(lds, g, S, E); }
    if (PH(2)) { pg8::Gemm g{(const bf16_t*)(ws + WS_H), (const bf16_t*)(ws + WS_WIN), MT, INP, 256, DM, DM}; pg8::CtxSplitOrder S{blk};
      pg8::EpiSlab E{(float*)(ws + WS_SLAB)};
      pg8::gemm_phase<pg8::EpiSlab, pg8::CtxSplitOrder, true>(lds, g, S, E); }
    SEAM();
    if (PH(3)) phase_prep(p, G);
    SEAM();
    if (PH(4)) { pg8::Gemm g{(const bf16_t*)(ws + WS_QN), (const bf16_t*)(ws + WS_WQB), ML, QW, QRANK, QRANK, QRANK}; pg8::StaticOrder S; S.init(ML, QW, G, blk);
      pg8::EpiRopeQ E{(bf16_t*)(ws + WS_Q), (const f32x2*)(ws + WS_ROPE)};
      pg8::gemm_phase<pg8::EpiRopeQ, pg8::StaticOrder, true>(lds, g, S, E); }
    if (PH(4)) { pg8::Gemm g{(const bf16_t*)(ws + WS_KVN), (const bf16_t*)(ws + WS_WKVB), MT, KVW, KVRANK, KVRANK, KVRANK}; pg8::StaticOrder S; S.init(MT, KVW, G, blk);
      pg8::EpiBf16 E{(bf16_t*)(ws + WS_KV), KVW};
      pg8::gemm_phase<pg8::EpiBf16, pg8::StaticOrder, true>(lds, g, S, E); }
    SEAM();
    if (PH(5)) { const int vcu = (G % 8 == 0) ? (blk % 8) * (G / 8) + blk / 8 : blk;
      for (int u = vcu; u < NB * NH * 8; u += G) { const int bh = u >> 3, qb = u & 7;
        att::attn_unit(bh >> 3, bh & 7, qb, (const bf16_t*)(ws + WS_Q), (const bf16_t*)(ws + WS_KV), (const bf16_t*)(ws + WS_KR), p.g_mix_out, (bf16_t*)(ws + WS_MIXN), (LAS char*)lds); } }
    SEAM();
    if (PH(6)) { pg8::Gemm g{(const bf16_t*)(ws + WS_MIXN), (const bf16_t*)(ws + WS_WOUT), ML, DM, DM, DM, DM}; pg8::StaticOrder S; S.init(ML, DM, G, blk);
      pg8::RowStats st{(float*)(ws + WS_XBUF), (unsigned*)(ws + WS_CNT)};
      pg8::EpiResGateNormMod E{p.x, p.out, mod + 2 * DM, p.g_ffn_norm, mod + 3 * DM, mod + 4 * DM, (bf16_t*)(ws + WS_H), st};
      pg8::gemm_phase<pg8::EpiResGateNormMod, pg8::StaticOrder, false>(lds, g, S, E); }
    SEAM();
    if (PH(8)) { pg8::Gemm g{(const bf16_t*)(ws + WS_H), (const bf16_t*)(ws + WS_WUP), ML, FFN2, DM, DM, DM}; pg8::StaticOrder S; S.init(ML, FFN2, G, blk);
      pg8::EpiAct E{(bf16_t*)(ws + WS_ACT), (bf16_t*)(ws + WS_RAW), p.ffn_conv_w, p.ffn_conv_b};
      pg8::gemm_phase<pg8::EpiAct, pg8::StaticOrder, true>(lds, g, S, E);
      const int nun = (ML / 256) * (FFN2 / 256), rem = nun % G;
      if (rem != 0 && blk >= rem) { const int tidx = otid(), wv = tidx >> 6, ln = tidx & 63; LAS float* scr = (LAS float*)(lds + wv * 16640);
        for (int it = (blk - rem) * NWAVES + wv; it < I_DOWN; it += (G - rem) * NWAVES) p0_transpose_item(p.w_down, FFN, DM, (bf16_t*)(ws + WS_WDOWN), scr, it, ln); }
      else if (rem == 0) { const int tidx = otid(), wv = tidx >> 6, ln = tidx & 63; LAS float* scr = (LAS float*)(lds + wv * 16640);
        for (int it = blk * NWAVES + wv; it < I_DOWN; it += G * NWAVES) p0_transpose_item(p.w_down, FFN, DM, (bf16_t*)(ws + WS_WDOWN), scr, it, ln); } }
    SEAM();
    if (PH(10)) { pg8::Gemm g{(const bf16_t*)(ws + WS_ACT), (const bf16_t*)(ws + WS_WDOWN), ML, DM, FFN, FFN, FFN}; pg8::StaticOrder S; S.init(ML, DM, G, blk);
      { pg8::Unit u0; if (S.next(0, u0)) act_fixup_panel(p, u0.pm); }
      __syncthreads();
      pg8::RowStats st{(float*)(ws + WS_XBUF) + 32 * 256 * 8, (unsigned*)(ws + WS_CNT) + 32 * 64};
      pg8::EpiResGateNormFinal E{p.out, p.out, mod + 5 * DM, p.g_final, st};
      pg8::gemm_phase<pg8::EpiResGateNormFinal, pg8::StaticOrder, false>(lds, g, S, E); }
}

extern "C" void kernel_launch(void* const* d_in, const int* in_sizes, int n_in, void* d_out, int out_size, void* d_ws, size_t ws_size, hipStream_t stream) {
    static int grid = 0;
    if (grid == 0) {
        if (n_in != 22 || ws_size < WS_END) { fprintf(stderr, "kernel_launch: unexpected n_in %d / ws_size %zu (need %zu)\n", n_in, ws_size, (size_t)WS_END); grid = -1; return; }
        int dev = 0, cus = 0, per_cu = 0;
        hipGetDevice(&dev); hipDeviceGetAttribute(&cus, hipDeviceAttributeMultiprocessorCount, dev);
        if (hipFuncSetAttribute((const void*)fwd_megakernel, hipFuncAttributeMaxDynamicSharedMemorySize, LDS_BYTES) != hipSuccess) { fprintf(stderr, "kernel_launch: hipFuncSetAttribute failed\n"); grid = -1; return; }
        if (hipOccupancyMaxActiveBlocksPerMultiprocessor(&per_cu, (const void*)fwd_megakernel, NTHR, LDS_BYTES) != hipSuccess || per_cu < 1) { fprintf(stderr, "kernel_launch: occupancy query says %d\n", per_cu); per_cu = 1; }
        (void)hipGetLastError();
        grid = cus;
        if (grid != 256) { fprintf(stderr, "kernel_launch: built for a 256-CU device (got %d)\n", cus); grid = -1; return; }
    }
    if (grid < 0) return;
    hipMemsetAsync(d_ws, 0, WS_ZERO_BYTES, stream);
    Params p{};
    const float** pp = (const float**)&p;
    for (int i = 0; i < 22; ++i) pp[i] = (const float*)d_in[i];
    p.out = (float*)d_out; p.ws = (unsigned char*)d_ws;
    void* args[] = {&p};
    hipError_t e = hipLaunchCooperativeKernel((const void*)fwd_megakernel, dim3(grid), dim3(NTHR), args, LDS_BYTES, stream);
    if (e != hipSuccess) fprintf(stderr, "cooperative launch failed: %s (grid %d)\n", hipGetErrorString(e), grid);
}
```
